# Optimizing an MI355X kernel written in HIP

```python
import math
import jax, jax.numpy as jnp
from jax import lax
import numpy as np

D_MODEL = 2048
BATCH = 4
SEQ = 2048
DEPTH = 2

N_BRANCH = 4
W_BRANCH = D_MODEL // 4
W_SSM = W_BRANCH
W_POOL = W_BRANCH
W_CONV = W_BRANCH
W_GMLP = W_BRANCH
SSM_GROUP = 16
SSM_GROUPS = W_SSM // SSM_GROUP
SSM_STATE = 64
POOL_WINDOWS = (2, 4, 8, 16)
POOL_GROUPS = len(POOL_WINDOWS)
POOL_GW = W_POOL // POOL_GROUPS
CONV_WIDTH = 31
GMLP_CHUNK = 128
GMLP_HEADS = 4
GMLP_HD = W_GMLP // GMLP_HEADS
D_FF = 4 * D_MODEL
EPS = 1e-6

OFF_SSM = 0
OFF_POOL = OFF_SSM + W_SSM
OFF_CONV = OFF_POOL + W_POOL
OFF_GMLP = OFF_CONV + 2 * W_CONV
OFF_GATE = OFF_GMLP + 2 * W_GMLP
IN_COLS = OFF_GATE + N_BRANCH * D_MODEL

kernel_name = 'hybrid_s5_pool_conv_gmlp_block'


def rms_norm(x, g):
    xf = x.astype(jnp.float32)
    y = xf * lax.rsqrt(jnp.mean(xf * xf, axis=-1, keepdims=True) + EPS)
    return (y * g.astype(jnp.float32)).astype(x.dtype)


def layer_norm(x, g, b):
    xf = x.astype(jnp.float32)
    mu = jnp.mean(xf, axis=-1, keepdims=True)
    xc = xf - mu
    var = jnp.mean(xc * xc, axis=-1, keepdims=True)
    y = xc * lax.rsqrt(var + EPS)
    return (y * g.astype(jnp.float32) + b.astype(jnp.float32)).astype(x.dtype)


def s5_mixer(u, a_re, a_im, log_dt, b_re, b_im, c_re, c_im, d_skip, w_glu):
    nb, L, _ = u.shape
    uf = u.astype(jnp.float32)
    ug = uf.reshape(nb, L, SSM_GROUPS, SSM_GROUP)
    dt = jnp.exp(log_dt.astype(jnp.float32))[:, None]
    ar = a_re.astype(jnp.float32)
    ai = a_im.astype(jnp.float32)
    mag = jnp.exp(ar * dt)
    ang = ai * dt
    lr = mag * jnp.cos(ang)
    li = mag * jnp.sin(ang)
    den = ar * ar + ai * ai
    fr = ((lr - 1.0) * ar + li * ai) / den
    fi = (li * ar - (lr - 1.0) * ai) / den
    br = b_re.astype(jnp.float32)
    bi = b_im.astype(jnp.float32)
    bbr = fr[:, :, None] * br - fi[:, :, None] * bi
    bbi = fr[:, :, None] * bi + fi[:, :, None] * br
    bur = jnp.einsum('gnp,blgp->blgn', bbr, ug)
    bui = jnp.einsum('gnp,blgp->blgn', bbi, ug)
    lam_r = jnp.broadcast_to(lr, bur.shape)
    lam_i = jnp.broadcast_to(li, bur.shape)

    def combine(e1, e2):
        a1r, a1i, b1r, b1i = e1
        a2r, a2i, b2r, b2i = e2
        return (a1r * a2r - a1i * a2i,
                a1r * a2i + a1i * a2r,
                a2r * b1r - a2i * b1i + b2r,
                a2r * b1i + a2i * b1r + b2i)

    _, _, sr, si = lax.associative_scan(combine, (lam_r, lam_i, bur, bui), axis=1)
    y = (jnp.einsum('gpn,blgn->blgp', c_re.astype(jnp.float32), sr)
         - jnp.einsum('gpn,blgn->blgp', c_im.astype(jnp.float32), si))
    y = y.reshape(nb, L, W_SSM) + d_skip.astype(jnp.float32) * uf
    z = jax.nn.gelu(y)
    zg = z @ w_glu.astype(jnp.float32)
    out = zg[..., :W_SSM] * jax.nn.sigmoid(zg[..., W_SSM:])
    return out.astype(u.dtype)


def pool_mixer(u, w_pool, pool_scale):
    nb, L, _ = u.shape
    uf = u.astype(jnp.float32)
    cs = jnp.pad(jnp.cumsum(uf, axis=1), ((0, 0), (1, 0), (0, 0)))
    t = jnp.arange(L)
    outs = []
    for gi, w in enumerate(POOL_WINDOWS):
        c = cs[:, :, gi * POOL_GW:(gi + 1) * POOL_GW]
        upper = c[:, 1:]
        lower = jnp.pad(c[:, :L + 1 - w], ((0, 0), (w - 1, 0), (0, 0)))
        count = jnp.minimum(t + 1, w).astype(jnp.float32)[None, :, None]
        mean = (upper - lower) / count
        outs.append(mean - uf[:, :, gi * POOL_GW:(gi + 1) * POOL_GW])
    pooled = jnp.stack(outs, axis=2)
    mixed = jnp.einsum('blgc,gcd->blgd', pooled, w_pool.astype(jnp.float32))
    out = mixed.reshape(nb, L, W_POOL) * pool_scale.astype(jnp.float32)
    return out.astype(u.dtype)


def conv_mixer(val, gate, w_dw, b_dw, ln_g, ln_b):
    v = val * jax.nn.sigmoid(gate)
    kern = w_dw.astype(v.dtype).reshape(CONV_WIDTH, 1, W_CONV)
    y = lax.conv_general_dilated(v, kern, window_strides=(1,), padding=[(CONV_WIDTH - 1, 0)],
                                 dimension_numbers=('NWC', 'WIO', 'NWC'),
                                 feature_group_count=W_CONV)
    y = y + b_dw.astype(y.dtype)
    y = layer_norm(y, ln_g, ln_b)
    return jax.nn.silu(y)


def gmlp_mixer(u, v, ln_g, ln_b, w_s, b_s):
    nb, L, _ = u.shape
    u = jax.nn.gelu(u)
    v = layer_norm(jax.nn.gelu(v), ln_g, ln_b)
    nc = L // GMLP_CHUNK
    vc = v.reshape(nb, nc, GMLP_CHUNK, GMLP_HEADS, GMLP_HD)
    mask = jnp.tril(jnp.ones((GMLP_CHUNK, GMLP_CHUNK), dtype=bool))
    ws = jnp.where(mask[None], w_s, jnp.zeros_like(w_s))
    sv = jnp.einsum('hts,bcshd->bcthd', ws, vc) + jnp.transpose(b_s)[None, None, :, :, None]
    return u * sv.reshape(nb, L, W_GMLP).astype(u.dtype)


def setup_inputs(seed: int = 0) -> dict:
    key = jax.random.key(seed)
    ks = iter(jax.random.split(key, 40))

    def nrm(shape, scale):
        return jax.random.normal(next(ks), shape, jnp.float32) * scale

    def gain(shape):
        return 1.0 + nrm(shape, 0.02)

    G, N, P = SSM_GROUPS, SSM_STATE, SSM_GROUP
    x = jax.random.normal(next(ks), (BATCH, SEQ, D_MODEL), jnp.float32)
    a_re = -0.5 + nrm((DEPTH, G, N), 0.01)
    a_im = jnp.pi * jnp.arange(N, dtype=jnp.float32)[None, None, :] + nrm((DEPTH, G, N), 0.01)
    log_dt = jax.random.uniform(next(ks), (DEPTH, G), jnp.float32,
                                minval=math.log(1e-3), maxval=math.log(1e-1))
    return {
        'x': x,
        'g_pre_mix': gain((DEPTH, D_MODEL)),
        'w_in': nrm((DEPTH, D_MODEL, IN_COLS), D_MODEL ** -0.5),
        'ssm_a_re': a_re,
        'ssm_a_im': a_im,
        'ssm_log_dt': log_dt,
        'ssm_b_re': nrm((DEPTH, G, N, P), (2 * P) ** -0.5),
        'ssm_b_im': nrm((DEPTH, G, N, P), (2 * P) ** -0.5),
        'ssm_c_re': nrm((DEPTH, G, P, N), (2 * N) ** -0.5),
        'ssm_c_im': nrm((DEPTH, G, P, N), (2 * N) ** -0.5),
        'ssm_d': nrm((DEPTH, W_SSM), 1.0),
        'ssm_w_glu': nrm((DEPTH, W_SSM, 2 * W_SSM), W_SSM ** -0.5),
        'pool_w': nrm((DEPTH, POOL_GROUPS, POOL_GW, POOL_GW), POOL_GW ** -0.5),
        'pool_scale': gain((DEPTH, W_POOL)),
        'conv_w': nrm((DEPTH, CONV_WIDTH, W_CONV), CONV_WIDTH ** -0.5),
        'conv_b': nrm((DEPTH, W_CONV), 0.02),
        'conv_ln_g': gain((DEPTH, W_CONV)),
        'conv_ln_b': nrm((DEPTH, W_CONV), 0.02),
        'gmlp_ln_g': gain((DEPTH, W_GMLP)),
        'gmlp_ln_b': nrm((DEPTH, W_GMLP), 0.02),
        'gmlp_ws': nrm((DEPTH, GMLP_HEADS, GMLP_CHUNK, GMLP_CHUNK), GMLP_CHUNK ** -0.5),
        'gmlp_bs': gain((DEPTH, GMLP_HEADS, GMLP_CHUNK)),
        'w_branch': nrm((DEPTH, N_BRANCH, W_BRANCH, D_MODEL), W_BRANCH ** -0.5),
        'w_o': nrm((DEPTH, D_MODEL, D_MODEL), D_MODEL ** -0.5),
        'g_post_mix': gain((DEPTH, D_MODEL)),
        'g_pre_mlp': gain((DEPTH, D_MODEL)),
        'w_ff1': nrm((DEPTH, D_MODEL, D_FF), D_MODEL ** -0.5),
        'w_ff2': nrm((DEPTH, D_FF, D_MODEL), D_FF ** -0.5),
        'g_post_mlp': gain((DEPTH, D_MODEL)),
    }


def reference(x, g_pre_mix, w_in, ssm_a_re, ssm_a_im, ssm_log_dt, ssm_b_re, ssm_b_im,
              ssm_c_re, ssm_c_im, ssm_d, ssm_w_glu, pool_w, pool_scale, conv_w, conv_b,
              conv_ln_g, conv_ln_b, gmlp_ln_g, gmlp_ln_b, gmlp_ws, gmlp_bs, w_branch, w_o,
              g_post_mix, g_pre_mlp, w_ff1, w_ff2, g_post_mlp):
    nb, L, _ = x.shape
    for l in range(DEPTH):
        h = rms_norm(x, g_pre_mix[l])
        proj = h @ w_in[l]
        y_ssm = s5_mixer(proj[..., OFF_SSM:OFF_SSM + W_SSM], ssm_a_re[l], ssm_a_im[l],
                         ssm_log_dt[l], ssm_b_re[l], ssm_b_im[l], ssm_c_re[l], ssm_c_im[l],
                         ssm_d[l], ssm_w_glu[l])
        y_pool = pool_mixer(proj[..., OFF_POOL:OFF_POOL + W_POOL], pool_w[l], pool_scale[l])
        y_conv = conv_mixer(proj[..., OFF_CONV:OFF_CONV + W_CONV],
                            proj[..., OFF_CONV + W_CONV:OFF_GMLP],
                            conv_w[l], conv_b[l], conv_ln_g[l], conv_ln_b[l])
        y_gmlp = gmlp_mixer(proj[..., OFF_GMLP:OFF_GMLP + W_GMLP],
                            proj[..., OFF_GMLP + W_GMLP:OFF_GATE],
                            gmlp_ln_g[l], gmlp_ln_b[l], gmlp_ws[l], gmlp_bs[l])
        ys = jnp.stack([y_ssm, y_pool, y_conv, y_gmlp], axis=2)
        yb = jnp.einsum('blkc,kcd->blkd', ys, w_branch[l])
        gates = jax.nn.sigmoid(
            proj[..., OFF_GATE:].reshape(nb, L, N_BRANCH, D_MODEL).astype(jnp.float32))
        merged = jnp.sum(yb.astype(jnp.float32) * gates, axis=2).astype(x.dtype)
        mix = merged @ w_o[l]
        x = x + rms_norm(mix, g_post_mix[l])
        h2 = rms_norm(x, g_pre_mlp[l])
        f = jnp.square(jax.nn.relu(h2 @ w_ff1[l])) @ w_ff2[l]
        x = x + rms_norm(f, g_post_mlp[l])
    return x
```

```cpp
#include <hip/hip_runtime.h>
#include <hip/hip_cooperative_groups.h>
#include <cstdio>
#include <cstdint>
namespace cg = cooperative_groups;

namespace pg8 {
#define PG8_LAS __attribute__((address_space(3)))
typedef unsigned short bf16_t;
typedef short bf16x8 __attribute__((ext_vector_type(8)));
typedef float f32x4 __attribute__((ext_vector_type(4)));
typedef unsigned u32x4 __attribute__((ext_vector_type(4)));
typedef unsigned u32x2 __attribute__((ext_vector_type(2)));
constexpr int BM = 256, BK = 64, HALF = 128, HTB = HALF * BK * 2  , STAGE_BYTES = 8 * HTB, NXCD = 8, WGM = 8;

__host__ __device__ __forceinline__ int lds_byte(int r, int c) { const int st = (r >> 4) * 2 + (c >> 5), rr = r & 15, cc = c & 31, ob = rr * 64 + cc * 2; return st * 1024 + (ob ^ (((ob >> 9) & 1) << 5)); }
__host__ __device__ __forceinline__ void stage_rc(int b, int& R, int& C) { const int st = b / 1024, sb = b % 1024, swz = sb ^ (((sb >> 9) & 1) << 5); R = (st >> 1) * 16 + swz / 64; C = (st & 1) * 32 + (swz % 64) / 2; }
__host__ __device__ __forceinline__ int perm32(int rho) { const int n = rho >> 4, i = rho & 15; return 8 * (i >> 2) + 4 * n + (i & 3); }

struct Unit { int pm, pn, seg; };
struct Gemm { const bf16_t* A; const bf16_t* Bt; int M, N, K, lda, ldb, a_pn_off; };

struct StaticOrder {
    int nM, nN, nwg, G, c;
    __host__ __device__ void init(int M, int N, int G_, int c_) { nM = M / BM; nN = N / BM; nwg = nM * nN; G = G_; c = c_; }
    __host__ __device__ bool next(int i, Unit& u) const {
        const long L = (long)i * G + c; if (c < 0 || L >= nwg) return false;
        int wgid = (int)L; { const int q = nwg / NXCD, r = nwg % NXCD, xcd = wgid % NXCD, off = wgid / NXCD; wgid = (xcd < r ? xcd * (q + 1) : r * (q + 1) + (xcd - r) * q) + off; }
        const int nig = WGM * nN, gid = wgid / nig, fm = gid * WGM, gsz = (nM - fm) < WGM ? (nM - fm) : WGM;
        u.pm = fm + ((wgid % nig) % gsz); u.pn = (wgid % nig) / gsz; u.seg = 0; return true;
    }
    __device__ __forceinline__ void a_ready(const Unit&) const {}
    __device__ __forceinline__ void done(const Unit&) const {}
};
struct SegOrder : StaticOrder {
    __host__ __device__ bool next(int i, Unit& u) const { if (!StaticOrder::next(i >> 2, u)) return false; u.seg = i & 3; return true; }
};

__device__ __forceinline__ unsigned cvt_pk_bf16(float lo, float hi) { unsigned r; asm volatile("v_cvt_pk_bf16_f32 %0, %1, %2" : "=v"(r) : "v"(lo), "v"(hi)); return r; }
__device__ __forceinline__ float bf_lo(unsigned w) { return __uint_as_float(w << 16); }
__device__ __forceinline__ float bf_hi(unsigned w) { return __uint_as_float(w & 0xffff0000u); }
__device__ __forceinline__ float sigm(float x) { return __builtin_amdgcn_rcpf(1.0f + __expf(-x)); }

struct EpiF32 {
    static constexpr bool PERM = false, AFTER_DRAIN = false, KHOOK = false;
    float* C; int ldc;
    __device__ __forceinline__ void operator()(f32x4 (&acc)[2][2][4][2], const Unit& u, int wr, int wc, int fr, int fq) const {
        const int row0 = u.pm * BM + wr * 64 + fr, col0 = u.pn * BM + wc * 32 + 4 * fq;
#pragma unroll
        for (int ai = 0; ai < 2; ++ai)
#pragma unroll
            for (int m = 0; m < 4; ++m) { float* rowp = C + (size_t)(row0 + ai * HALF + m * 16) * ldc + col0;
#pragma unroll
                for (int bj = 0; bj < 2; ++bj)
#pragma unroll
                    for (int n = 0; n < 2; ++n) *(f32x4*)(rowp + bj * HALF + n * 16) = acc[ai][bj][m][n]; }
    }
};
template <int ACT> struct EpiBf16 {
    static constexpr bool PERM = true, AFTER_DRAIN = false, KHOOK = false;
    bf16_t* O; int ldc; bf16_t* O2; int ldc2; const float* scale; int coff;
    __device__ __forceinline__ void operator()(f32x4 (&acc)[2][2][4][2], const Unit& u, int wr, int wc, int fr, int fq) const {
        const int row0 = u.pm * BM + wr * 64 + fr; int colt = u.pn * BM; bf16_t* base = O; int ld = ldc; bool sg = false;
        if (ACT == 0 && u.pn >= 12) { base = O2; ld = ldc2; colt -= 12 * BM; sg = true; }
        const int col0 = colt + wc * 32 + 8 * fq + (ACT == 2 ? coff : 0), scol0 = u.pn * BM + wc * 32 + 8 * fq;
#pragma unroll
        for (int ai = 0; ai < 2; ++ai)
#pragma unroll
            for (int m = 0; m < 4; ++m) { bf16_t* rowp = base + (size_t)(row0 + ai * HALF + m * 16) * ld + col0;
#pragma unroll
                for (int bj = 0; bj < 2; ++bj) { f32x4 v0 = acc[ai][bj][m][0], v1 = acc[ai][bj][m][1];
                    if (ACT == 0) { if (sg) {
#pragma unroll
                        for (int j = 0; j < 4; ++j) { v0[j] = sigm(fmaxf(v0[j], -30.f)); v1[j] = sigm(fmaxf(v1[j], -30.f)); } } }
                    if (ACT == 1) {
#pragma unroll
                        for (int j = 0; j < 4; ++j) { const float a = fmaxf(v0[j], 0.f), b = fmaxf(v1[j], 0.f); v0[j] = a * a; v1[j] = b * b; } }
                    if (ACT == 2) { const f32x4 s0 = *(const f32x4*)(scale + scol0 + bj * HALF), s1 = *(const f32x4*)(scale + scol0 + bj * HALF + 4); v0 = v0 * s0; v1 = v1 * s1; }
                    u32x4 w; w.x = cvt_pk_bf16(v0[0], v0[1]); w.y = cvt_pk_bf16(v0[2], v0[3]); w.z = cvt_pk_bf16(v1[0], v1[1]); w.w = cvt_pk_bf16(v1[2], v1[3]);
                    *(u32x4*)(rowp + bj * HALF) = w; } }
    }
};
struct EpiGlu {
    static constexpr bool PERM = true, AFTER_DRAIN = false, KHOOK = false;
    bf16_t* O; int ldc;
    __device__ __forceinline__ void operator()(f32x4 (&acc)[2][2][4][2], const Unit& u, int wr, int wc, int fr, int fq) const {
        const int row0 = u.pm * BM + wr * 64 + fr, col0 = u.pn * HALF + wc * 32 + 8 * fq;
#pragma unroll
        for (int ai = 0; ai < 2; ++ai)
#pragma unroll
            for (int m = 0; m < 4; ++m) { bf16_t* rowp = O + (size_t)(row0 + ai * HALF + m * 16) * ldc + col0;
                f32x4 v0 = acc[ai][0][m][0], v1 = acc[ai][0][m][1]; const f32x4 g0 = acc[ai][1][m][0], g1 = acc[ai][1][m][1];
#pragma unroll
                for (int j = 0; j < 4; ++j) { v0[j] *= sigm(g0[j]); v1[j] *= sigm(g1[j]); }
                u32x4 w; w.x = cvt_pk_bf16(v0[0], v0[1]); w.y = cvt_pk_bf16(v0[2], v0[3]); w.z = cvt_pk_bf16(v1[0], v1[1]); w.w = cvt_pk_bf16(v1[2], v1[3]);
                *(u32x4*)rowp = w; }
    }
};
struct EpiBranch {
    static constexpr bool PERM = true, AFTER_DRAIN = false, KHOOK = true;
    bf16_t* O; int ldc; const bf16_t* Gt;
    __device__ __forceinline__ void khook(f32x4 (&acc)[2][2][4][2], const Unit& u, int seg, int wr, int wc, int fr, int fq) const {
        int row0 = u.pm * BM + wr * 64 + fr, col0 = u.pn * BM + wc * 32 + 8 * fq;
        asm volatile("" : "+v"(row0), "+v"(col0));
        const bool lastseg = (seg >= 3); const int nxt = lastseg ? 0 : 2048;
#pragma unroll
        for (int ai = 0; ai < 2; ++ai)
#pragma unroll
            for (int m = 0; m < 4; ++m) {
#pragma unroll
                for (int bj = 0; bj < 2; ++bj) { const bf16_t* gp = Gt + (size_t)(row0 + ai * HALF + m * 16) * 8192 + seg * 2048 + col0 + bj * HALF;
                    const u32x4 a = *(const u32x4*)gp; const u32x4 b = *(const u32x4*)(gp + nxt);
                    f32x4 r0 = (f32x4){bf_lo(a.x), bf_hi(a.x), bf_lo(a.y), bf_hi(a.y)}, r1 = (f32x4){bf_lo(a.z), bf_hi(a.z), bf_lo(a.w), bf_hi(a.w)};
                    f32x4 q0 = (f32x4){bf_lo(b.x), bf_hi(b.x), bf_lo(b.y), bf_hi(b.y)}, q1 = (f32x4){bf_lo(b.z), bf_hi(b.z), bf_lo(b.w), bf_hi(b.w)};
#pragma unroll
                    for (int j = 0; j < 4; ++j) { q0[j] = lastseg ? 1.0f : __builtin_amdgcn_rcpf(q0[j]); q1[j] = lastseg ? 1.0f : __builtin_amdgcn_rcpf(q1[j]); }
                    acc[ai][bj][m][0] = acc[ai][bj][m][0] * (r0 * q0); acc[ai][bj][m][1] = acc[ai][bj][m][1] * (r1 * q1); }
                asm volatile("" ::: "memory"); }
    }
    __device__ __forceinline__ void operator()(f32x4 (&acc)[2][2][4][2], const Unit& u, int wr, int wc, int fr, int fq) const {
        khook(acc, u, u.seg, wr, wc, fr, fq);
        if (u.seg != 3) return;
        const int row0 = u.pm * BM + wr * 64 + fr, col0 = u.pn * BM + wc * 32 + 8 * fq;
#pragma unroll
        for (int ai = 0; ai < 2; ++ai)
#pragma unroll
            for (int m = 0; m < 4; ++m) { bf16_t* rowp = O + (size_t)(row0 + ai * HALF + m * 16) * ldc + col0;
#pragma unroll
                for (int bj = 0; bj < 2; ++bj) { const f32x4 v0 = acc[ai][bj][m][0], v1 = acc[ai][bj][m][1];
                    u32x4 w; w.x = cvt_pk_bf16(v0[0], v0[1]); w.y = cvt_pk_bf16(v0[2], v0[3]); w.z = cvt_pk_bf16(v1[0], v1[1]); w.w = cvt_pk_bf16(v1[2], v1[3]);
                    *(u32x4*)(rowp + bj * HALF) = w; } }
    }
};
template <class Epi, class Sched, bool ALIGN_EPI = false, bool SP2 = false>
__device__ __forceinline__ void gemm_phase(PG8_LAS unsigned char* lds, const Gemm g, const Sched& S, const Epi& E, const int wave_in, const int lane_in) {
    int tid = wave_in * 64 + lane_in; asm volatile("" : "+v"(tid));
    const int wid = wave_in, lane = tid & 63, wr = wid >> 2, wc = wid & 3, fr = lane & 15, fq = lane >> 4;
    const int K = g.K, nt = K / BK;
    unsigned voffA[2], voffB[2];
#pragma unroll
    for (int i = 0; i < 2; ++i) { int R, C; stage_rc(tid * 16 + i * 8192, R, C); const int Rb = Epi::PERM ? ((R & ~31) + perm32(R & 31)) : R;
        voffA[i] = (unsigned)(R * g.lda + C) * 2u; voffB[i] = (unsigned)(Rb * g.ldb + C) * 2u; }
    constexpr unsigned kstep = BK * 2;
    const unsigned hstepA = (unsigned)HALF * g.lda * 2u, hstepB = (unsigned)HALF * g.ldb * 2u;
    const unsigned tstepA = 2u * hstepA, tstepB = 2u * hstepB;
    const unsigned pnoff = (unsigned)g.a_pn_off * 2u;
    const unsigned ldsw = (unsigned)wid * 1024u;
    const int aoff = lds_byte(wr * 64 + fr, fq * 8), boff = lds_byte(wc * 32 + fr, fq * 8);
#define PG8_SA(b, h) (((b) * 2 + (h)) * HTB)
#define PG8_SB(b, h) ((4 + (b) * 2 + (h)) * HTB)
#define PG8_STAGE(bufoff, gbase, voff) do { _Pragma("unroll") for (int _i = 0; _i < 2; ++_i) \
        __builtin_amdgcn_global_load_lds((const unsigned*)((const char*)(gbase) + (voff)[_i]), (PG8_LAS unsigned*)(lds + (bufoff) + ldsw + _i * 8192), 16, 0, 0); } while (0)
#define PG8_LDA(dst, b, h) do { _Pragma("unroll") for (int m = 0; m < 4; ++m) _Pragma("unroll") for (int k = 0; k < 2; ++k) dst[m][k] = *(const PG8_LAS bf16x8*)(lds + PG8_SA(b, h) + aoff + m * 2048 + k * 1024); } while (0)
#define PG8_LDB(dst, b, h) do { _Pragma("unroll") for (int n = 0; n < 2; ++n) _Pragma("unroll") for (int k = 0; k < 2; ++k) dst[n][k] = *(const PG8_LAS bf16x8*)(lds + PG8_SB(b, h) + boff + n * 2048 + k * 1024); } while (0)
#define PG8_MMA(ai, bj, At, Bt) do { __builtin_amdgcn_s_setprio(1); _Pragma("unroll") for (int m = 0; m < 4; ++m) _Pragma("unroll") for (int n = 0; n < 2; ++n) _Pragma("unroll") for (int k = 0; k < 2; ++k) \
        acc[ai][bj][m][n] = __builtin_amdgcn_mfma_f32_16x16x32_bf16(Bt[n][k], At[m][k], acc[ai][bj][m][n], 0, 0, 0); __builtin_amdgcn_s_setprio(0); } while (0)
#define PG8_WAIT_V(n) asm volatile("s_waitcnt vmcnt(" #n ")" ::: "memory")
#define PG8_WAIT_L(n) asm volatile("s_waitcnt lgkmcnt(" #n ")" ::: "memory")
#define PG8_BAR __builtin_amdgcn_s_barrier()
#define PG8_SCHED __builtin_amdgcn_sched_barrier(0)
    Unit cur, nxt; int ui = 0;
    if (!S.next(0, cur)) return;
    f32x4 acc[2][2][4][2];
#pragma unroll
    for (int a = 0; a < 2; ++a)
#pragma unroll
        for (int b = 0; b < 2; ++b)
#pragma unroll
            for (int m = 0; m < 4; ++m)
#pragma unroll
                for (int n = 0; n < 2; ++n) acc[a][b][m][n] = (f32x4){0.f, 0.f, 0.f, 0.f};
    bf16x8 At[4][2], B0[2][2], B1[2][2];
    const unsigned segoff = Epi::KHOOK ? (unsigned)K * 2u : 0u;
    const char* cA = (const char*)g.A + ((unsigned)cur.pm * tstepA + (unsigned)cur.pn * pnoff + (unsigned)cur.seg * segoff); const char* cB = (const char*)g.Bt + ((unsigned)cur.pn * tstepB + (unsigned)cur.seg * segoff);
    S.a_ready(cur);
    if constexpr (SP2) {
        PG8_STAGE(PG8_SB(0, 0), cB, voffB); PG8_STAGE(PG8_SB(0, 1), cB + hstepB, voffB); PG8_STAGE(PG8_SA(0, 0), cA, voffA); PG8_STAGE(PG8_SA(0, 1), cA + hstepA, voffA);
        if (wr == 1) PG8_BAR;
        PG8_WAIT_V(2); PG8_BAR;
        PG8_STAGE(PG8_SB(1, 0), cB + kstep, voffB); PG8_STAGE(PG8_SA(1, 0), cA + kstep, voffA); PG8_STAGE(PG8_SB(1, 1), cB + hstepB + kstep, voffB);
        PG8_WAIT_V(6); PG8_BAR;
    } else {
        PG8_STAGE(PG8_SB(0, 0), cB, voffB); PG8_STAGE(PG8_SA(0, 0), cA, voffA); PG8_STAGE(PG8_SB(0, 1), cB + hstepB, voffB); PG8_STAGE(PG8_SA(0, 1), cA + hstepA, voffA);
        if (wr == 1) PG8_BAR;
        PG8_WAIT_V(4); PG8_BAR;
        PG8_STAGE(PG8_SB(1, 0), cB + kstep, voffB); PG8_STAGE(PG8_SA(1, 0), cA + kstep, voffA); PG8_STAGE(PG8_SB(1, 1), cB + hstepB + kstep, voffB);
        PG8_WAIT_V(6); PG8_BAR;
    }
    for (;;) {
        const bool has_next = S.next(ui + 1, nxt);
        const char* nA = has_next ? (const char*)g.A + ((unsigned)nxt.pm * tstepA + (unsigned)nxt.pn * pnoff + (unsigned)nxt.seg * segoff) : cA; const char* nB = has_next ? (const char*)g.Bt + ((unsigned)nxt.pn * tstepB + (unsigned)nxt.seg * segoff) : cB;
        for (int t = 0; t < nt; t += 2) {
            const bool last = (t == nt - 2);
            const char* a1 = cA + (unsigned)(t + 1) * kstep;
            const char* a2 = last ? nA : cA + (unsigned)(t + 2) * kstep; const char* b2 = last ? nB : cB + (unsigned)(t + 2) * kstep;
            const char* a3 = a2 + kstep; const char* b3 = b2 + kstep;
            if (last && has_next) S.a_ready(nxt);
            if constexpr (SP2) {
            PG8_LDB(B0, 0, 0); PG8_LDB(B1, 0, 1); PG8_SCHED; PG8_LDA(At, 0, 0); PG8_STAGE(PG8_SA(1, 1), a1 + hstepA, voffA);
            PG8_WAIT_V(8); PG8_WAIT_L(0); PG8_BAR; PG8_MMA(0, 0, At, B0); PG8_MMA(0, 1, At, B1); PG8_BAR; PG8_SCHED;
            PG8_LDA(At, 0, 1); PG8_STAGE(PG8_SB(0, 0), b2, voffB); PG8_STAGE(PG8_SB(0, 1), b2 + hstepB, voffB); PG8_STAGE(PG8_SA(0, 0), a2, voffA);
            PG8_WAIT_V(8); PG8_WAIT_L(0); PG8_BAR; PG8_MMA(1, 0, At, B0); PG8_MMA(1, 1, At, B1); PG8_BAR; PG8_SCHED;
            PG8_LDB(B0, 1, 0); PG8_LDB(B1, 1, 1); PG8_SCHED; PG8_LDA(At, 1, 0); PG8_STAGE(PG8_SA(0, 1), a2 + hstepA, voffA);
            PG8_WAIT_V(8); PG8_WAIT_L(0); PG8_BAR; PG8_MMA(0, 0, At, B0); PG8_MMA(0, 1, At, B1); PG8_BAR; PG8_SCHED;
            PG8_LDA(At, 1, 1); PG8_STAGE(PG8_SB(1, 0), b3, voffB); PG8_STAGE(PG8_SB(1, 1), b3 + hstepB, voffB); PG8_STAGE(PG8_SA(1, 0), a3, voffA);
            PG8_WAIT_V(8); PG8_WAIT_L(0); PG8_BAR; PG8_MMA(1, 0, At, B0); PG8_MMA(1, 1, At, B1); PG8_BAR; PG8_SCHED;
            } else {
            PG8_LDB(B0, 0, 0); PG8_SCHED; PG8_LDA(At, 0, 0); PG8_STAGE(PG8_SA(1, 1), a1 + hstepA, voffA);
            PG8_WAIT_L(8); PG8_BAR; PG8_WAIT_L(0); PG8_MMA(0, 0, At, B0); PG8_BAR; PG8_SCHED;
            PG8_LDB(B1, 0, 1); PG8_STAGE(PG8_SB(0, 0), b2, voffB);
            PG8_BAR; PG8_WAIT_L(0); PG8_MMA(0, 1, At, B1); PG8_BAR;
            PG8_LDA(At, 0, 1); PG8_STAGE(PG8_SA(0, 0), a2, voffA);
            PG8_BAR; PG8_WAIT_L(0); PG8_MMA(1, 0, At, B0); PG8_BAR; PG8_SCHED;
            PG8_STAGE(PG8_SB(0, 1), b2 + hstepB, voffB);
            PG8_WAIT_V(6); PG8_BAR; PG8_MMA(1, 1, At, B1); PG8_BAR;
            PG8_LDB(B0, 1, 0); PG8_SCHED; PG8_LDA(At, 1, 0); PG8_STAGE(PG8_SA(0, 1), a2 + hstepA, voffA);
            PG8_WAIT_L(8); PG8_BAR; PG8_WAIT_L(0); PG8_MMA(0, 0, At, B0); PG8_BAR; PG8_SCHED;
            PG8_LDB(B1, 1, 1); PG8_STAGE(PG8_SB(1, 0), b3, voffB);
            PG8_BAR; PG8_WAIT_L(0); PG8_MMA(0, 1, At, B1); PG8_BAR;
            PG8_LDA(At, 1, 1); PG8_STAGE(PG8_SA(1, 0), a3, voffA);
            PG8_BAR; PG8_WAIT_L(0); PG8_MMA(1, 0, At, B0); PG8_BAR; PG8_SCHED;
            PG8_STAGE(PG8_SB(1, 1), b3 + hstepB, voffB);
            PG8_WAIT_V(6); PG8_BAR; PG8_MMA(1, 1, At, B1); PG8_BAR;
            }
        }
        if constexpr (ALIGN_EPI) { if (wr == 0) PG8_BAR; }
        if constexpr (!Epi::AFTER_DRAIN) { int l2 = lane_in; asm volatile("" : "+v"(l2)); E(acc, cur, wr, wc, l2 & 15, l2 >> 4); S.done(cur); }
        if (!has_next) break;
        if (!Epi::KHOOK || cur.seg == 3)
#pragma unroll
        for (int a = 0; a < 2; ++a)
#pragma unroll
            for (int b = 0; b < 2; ++b)
#pragma unroll
                for (int m = 0; m < 4; ++m)
#pragma unroll
                    for (int n = 0; n < 2; ++n) acc[a][b][m][n] = (f32x4){0.f, 0.f, 0.f, 0.f};
        cur = nxt; cA = nA; cB = nB; ++ui;
        if constexpr (ALIGN_EPI) { if (wr == 1) PG8_BAR; }
    }
    PG8_WAIT_V(0);
    if constexpr (!ALIGN_EPI) { if (wr == 0) PG8_BAR; }
    PG8_BAR;
    if constexpr (Epi::AFTER_DRAIN) { E.fused(acc, cur, wr, wc, fr, fq, lds, wid, lane); S.done(cur); }
#undef PG8_SA
#undef PG8_SB
#undef PG8_STAGE
#undef PG8_LDA
#undef PG8_LDB
#undef PG8_MMA
#undef PG8_WAIT_V
#undef PG8_WAIT_L
#undef PG8_BAR
#undef PG8_SCHED
}
}

constexpr int DM = 2048, NB = 4, SEQ = 2048, MTOK = NB * SEQ, DEPTH = 2;
constexpr int WBR = 512, INC = 11264, PCOLS = 3072, DFF = 8192;
constexpr float EPS = 1e-6f;
constexpr int NTHREADS = 512, NWAVES = 8;
constexpr int LDS_BYTES = 147456;

constexpr size_t MiB = (size_t)1 << 20;
constexpr size_t WS_WIN = 0, WS_WFF1 = 88 * MiB, WS_WFF2 = 152 * MiB, WS_WO = 216 * MiB, WS_WBR = 232 * MiB, WS_WGLU = 248 * MiB, WS_WPOOL = 250 * MiB, WS_SEND = 251 * MiB;
constexpr size_t WS_H = 254 * MiB, WS_P = 286 * MiB, WS_G = 334 * MiB, WS_YS = 462 * MiB, WS_Z = 494 * MiB, WS_POOLED = 502 * MiB, WS_MERGED = 510 * MiB, WS_MIX = 542 * MiB, WS_END = 606 * MiB;
constexpr size_t L_WIN = (size_t)INC * DM * 2, L_WFF = (size_t)DFF * DM * 2, L_WSQ = (size_t)DM * DM * 2, L_WGLU = (size_t)1024 * 512 * 2, L_WPOOL = (size_t)512 * 256 * 2;

typedef unsigned short bf16;
#define LAS __attribute__((address_space(3)))
typedef unsigned v4u __attribute__((ext_vector_type(4)));
typedef unsigned v2u __attribute__((ext_vector_type(2)));
typedef float v4f __attribute__((ext_vector_type(4)));
typedef float v2f __attribute__((ext_vector_type(2)));

struct Params { const float* in[29]; float* out; unsigned char* ws; };
typedef const Params __attribute__((address_space(4)))* KP;
__device__ __forceinline__ KP kargs() { KP q = (KP)__builtin_amdgcn_kernarg_segment_ptr(); asm volatile("" : "+s"(q)); return q; }

__device__ __forceinline__ unsigned f2bf(float f) { unsigned u = __float_as_uint(f); return (u + 0x7fffu + ((u >> 16) & 1u)) >> 16; }
__device__ __forceinline__ unsigned pk2(float lo, float hi) { return f2bf(lo) | (f2bf(hi) << 16); }
__device__ __forceinline__ float bflo(unsigned w) { return __uint_as_float(w << 16); }
__device__ __forceinline__ float bfhi(unsigned w) { return __uint_as_float(w & 0xffff0000u); }
__device__ __forceinline__ float bf1(const bf16* p) { return __uint_as_float(((unsigned)*p) << 16); }
__device__ __forceinline__ float sigmoid_f(float x) { return 1.0f / (1.0f + __expf(-x)); }
__device__ __forceinline__ float gelu_tanh(float x) { const float y = 1.5957691216057308f * (x + 0.044715f * x * x * x); return x / (1.0f + __expf(-y)); }
__device__ __forceinline__ float wave_sum(float v, int lane) {
#pragma unroll
    for (int o = 1; o < 64; o <<= 1) v += __builtin_bit_cast(float, __builtin_amdgcn_ds_bpermute((lane ^ o) << 2, __builtin_bit_cast(int, v)));
    return v;
}
#define LDS_WAIT() asm volatile("s_waitcnt lgkmcnt(0)" ::: "memory")

__device__ __forceinline__ void transpose_item(const float* W, int K, int N, bf16* WT, LAS float* scr, int item, int lane, int mode) {
    const int nblk = N / 32, kb = item / nblk, nb = item % nblk, k0 = 64 * kb, n0 = 32 * nb;
    int src0 = n0; if (mode == 1) { const int pn = n0 >> 8, bj = (n0 >> 7) & 1, j0 = n0 & 127; src0 = bj * 512 + pn * 128 + j0; }
#pragma unroll 8
    for (int i = 0; i < 32; ++i) { const int kk = 2 * i + (lane >> 5); scr[kk * 33 + (lane & 31)] = W[(size_t)(k0 + kk) * N + src0 + (lane & 31)]; }
    LDS_WAIT();
    const int c = lane & 7;
#pragma unroll
    for (int j = 0; j < 4; ++j) { const int n = (lane >> 3) + 8 * j; const LAS float* s = scr + (8 * c) * 33 + n;
        v4u o; o.x = pk2(s[0 * 33], s[1 * 33]); o.y = pk2(s[2 * 33], s[3 * 33]); o.z = pk2(s[4 * 33], s[5 * 33]); o.w = pk2(s[6 * 33], s[7 * 33]);
        *(v4u*)(WT + (size_t)(n0 + n) * K + k0 + 8 * c) = o; }
    LDS_WAIT();
}

__device__ __forceinline__ void rms_row_to_bf16(const float* xrow, const float* g, bf16* orow, int lane) {
    const v4f* xr = (const v4f*)xrow + lane; v4f v[8]; float s = 0.f;
#pragma unroll
    for (int j = 0; j < 8; ++j) { v[j] = xr[64 * j]; s += (v[j].x * v[j].x + v[j].y * v[j].y) + (v[j].z * v[j].z + v[j].w * v[j].w); }
    const float r = rsqrtf(wave_sum(s, lane) * (1.f / DM) + EPS);
    const v4f* gr = (const v4f*)g + lane; v2u* o8 = (v2u*)orow + lane;
#pragma unroll
    for (int j = 0; j < 8; ++j) { const v4f gg = gr[64 * j]; v2u o; o.x = pk2(v[j].x * r * gg.x, v[j].y * r * gg.y); o.y = pk2(v[j].z * r * gg.z, v[j].w * r * gg.w); o8[64 * j] = o; }
}
__device__ __forceinline__ void resid_norm_row(const float* yrow, const float* xi, float* xo, const float* g1, const float* g2, bf16* hn, int lane) {
    const v4f* yr = (const v4f*)yrow + lane; const v4f* xr = (const v4f*)xi + lane; v4f v[8]; float s = 0.f;
#pragma unroll
    for (int j = 0; j < 8; ++j) { v[j] = yr[64 * j]; s += (v[j].x * v[j].x + v[j].y * v[j].y) + (v[j].z * v[j].z + v[j].w * v[j].w); }
    const float r = rsqrtf(wave_sum(s, lane) * (1.f / DM) + EPS);
    const v4f* gr = (const v4f*)g1 + lane; v4f* xw = (v4f*)xo + lane; float s2 = 0.f;
#pragma unroll
    for (int j = 0; j < 8; ++j) { const v4f gg = gr[64 * j]; const v4f xx = xr[64 * j]; v[j] = xx + v[j] * r * gg; xw[64 * j] = v[j]; s2 += (v[j].x * v[j].x + v[j].y * v[j].y) + (v[j].z * v[j].z + v[j].w * v[j].w); }
    if (hn) { const float r2 = rsqrtf(wave_sum(s2, lane) * (1.f / DM) + EPS); const v4f* g2r = (const v4f*)g2 + lane; v2u* o8 = (v2u*)hn + lane;
#pragma unroll
        for (int j = 0; j < 8; ++j) { const v4f gg = g2r[64 * j]; v2u o; o.x = pk2(v[j].x * r2 * gg.x, v[j].y * r2 * gg.y); o.y = pk2(v[j].z * r2 * gg.z, v[j].w * r2 * gg.w); o8[64 * j] = o; } }
}

__device__ __forceinline__ void ssm_params(KP p, int l, int g, int n, float& lr, float& li, float (&bbr)[16], float (&bbi)[16]) {
    const float ar = p->in[3][(l * 32 + g) * 64 + n], ai = p->in[4][(l * 32 + g) * 64 + n];
    const float dt = expf(p->in[5][l * 32 + g]);
    const float mag = expf(ar * dt), ang = ai * dt;
    lr = mag * cosf(ang); li = mag * sinf(ang);
    const float den = ar * ar + ai * ai;
    const float fr = ((lr - 1.0f) * ar + li * ai) / den, fi = (li * ar - (lr - 1.0f) * ai) / den;
    const v4f* br = (const v4f*)(p->in[6] + ((size_t)(l * 32 + g) * 64 + n) * 16); const v4f* bi = (const v4f*)(p->in[7] + ((size_t)(l * 32 + g) * 64 + n) * 16);
#pragma unroll
    for (int q = 0; q < 4; ++q) { const v4f a = br[q], b = bi[q];
#pragma unroll
        for (int j = 0; j < 4; ++j) { bbr[4 * q + j] = fr * a[j] - fi * b[j]; bbi[4 * q + j] = fr * b[j] + fi * a[j]; } }
}
#define SSM_BU(t, br_, bi_) do { br_ = 0.f; bi_ = 0.f; _Pragma("unroll") for (int j = 0; j < 8; ++j) { const unsigned w_ = (unsigned)__builtin_amdgcn_readlane((int)ur[j], (t)); const float ua_ = bflo(w_), ub_ = bfhi(w_); \
        br_ = fmaf(bbr[2 * j], ua_, br_); br_ = fmaf(bbr[2 * j + 1], ub_, br_); bi_ = fmaf(bbi[2 * j], ua_, bi_); bi_ = fmaf(bbi[2 * j + 1], ub_, bi_); } } while (0)

__device__ __forceinline__ void ssm_pass1_job(KP p, int l, int job, int wave, int lane, const bf16* P, float* Send) {
    const int co = job & 3, g = (job >> 2) & 31, b = job >> 7, chunk = co * 8 + wave;
    float lr, li, bbr[16], bbi[16]; ssm_params(p, l, g, lane, lr, li, bbr, bbi);
    const size_t row0 = (size_t)b * SEQ + chunk * 64;
    const v4u* up = (const v4u*)(P + (row0 + lane) * PCOLS + g * 16);
    const v4u u0 = up[0], u1 = up[1]; const unsigned ur[8] = {u0.x, u0.y, u0.z, u0.w, u1.x, u1.y, u1.z, u1.w};
    float sr = 0.f, si = 0.f;
#pragma unroll 1
    for (int t = 0; t < 64; ++t) { float br_, bi_; SSM_BU(t, br_, bi_); const float nr = lr * sr - li * si + br_, ni = lr * si + li * sr + bi_; sr = nr; si = ni; }
    *(v2f*)(Send + ((size_t)((b * 32 + g) * 32 + chunk) * 64 + lane) * 2) = (v2f){sr, si};
}
__device__ __forceinline__ void ssm_pass2_job(KP p, int l, int job, int tid, int wave, int lane, const bf16* P, const float* Send, bf16* Z, LAS unsigned char* lds) {
    const int co = job & 3, g = (job >> 2) & 31, b = job >> 7, chunk = co * 8 + wave;
    LAS float* Cr = (LAS float*)lds; LAS float* Ci = (LAS float*)(lds + 4224);
    LAS float* Sr = (LAS float*)(lds + 8448 + wave * 8448); LAS float* Si = Sr + 16 * 65;
    for (int i = tid; i < 1024; i += NTHREADS) { const int pp = i >> 6, n = i & 63; Cr[pp * 65 + n] = p->in[8][(size_t)(l * 32 + g) * 1024 + i]; Ci[pp * 65 + n] = p->in[9][(size_t)(l * 32 + g) * 1024 + i]; }
    __syncthreads();
    float lr, li, bbr[16], bbi[16]; ssm_params(p, l, g, lane, lr, li, bbr, bbi);
    float pr = lr, pi = li;
#pragma unroll
    for (int q = 0; q < 6; ++q) { const float nr = pr * pr - pi * pi, ni = 2.f * pr * pi; pr = nr; pi = ni; }
    float sr = 0.f, si = 0.f;
    { const v2f* se = (const v2f*)Send + (size_t)((b * 32 + g) * 32) * 64 + lane;
      for (int c = 0; c < chunk; ++c) { const v2f e = se[(size_t)c * 64]; const float nr = pr * sr - pi * si + e.x, ni = pr * si + pi * sr + e.y; sr = nr; si = ni; } }
    const size_t row0 = (size_t)b * SEQ + chunk * 64;
    const v4u* up = (const v4u*)(P + (row0 + lane) * PCOLS + g * 16);
    const v4u u0 = up[0], u1 = up[1]; const unsigned ur[8] = {u0.x, u0.y, u0.z, u0.w, u1.x, u1.y, u1.z, u1.w};
    const int pp = lane & 15, tq = lane >> 4; const float dsk = p->in[10][l * 512 + g * 16 + pp];
#pragma unroll 1
    for (int sub = 0; sub < 4; ++sub) {
#pragma unroll 1
        for (int tt = 0; tt < 16; ++tt) { float br_, bi_; SSM_BU(sub * 16 + tt, br_, bi_); const float nr = lr * sr - li * si + br_, ni = lr * si + li * sr + bi_; sr = nr; si = ni; Sr[tt * 65 + lane] = sr; Si[tt * 65 + lane] = si; }
        LDS_WAIT(); __builtin_amdgcn_wave_barrier();
        float y[4] = {0.f, 0.f, 0.f, 0.f};
#pragma unroll 4
        for (int n = 0; n < 64; ++n) { const float cr = Cr[pp * 65 + n], ci = Ci[pp * 65 + n];
#pragma unroll
            for (int i = 0; i < 4; ++i) { y[i] = fmaf(cr, Sr[(tq * 4 + i) * 65 + n], y[i]); y[i] = fmaf(-ci, Si[(tq * 4 + i) * 65 + n], y[i]); } }
#pragma unroll
        for (int i = 0; i < 4; ++i) { const size_t row = row0 + sub * 16 + tq * 4 + i; const float uv = bf1(P + row * PCOLS + g * 16 + pp);
            Z[row * 512 + g * 16 + pp] = (bf16)f2bf(gelu_tanh(y[i] + dsk * uv)); }
        LDS_WAIT(); __builtin_amdgcn_wave_barrier();
    }
    __syncthreads();
}

__device__ __forceinline__ void pool_job(int job, int tid, const bf16* P, bf16* pooled) {
    const int b = job >> 6, t0 = (job & 63) * 32, c = tid, w = 2 << (c >> 7);
    const bf16* U = P + (size_t)b * SEQ * PCOLS + 512 + c;
    float sum = 0.f;
    for (int tt = t0 - w + 1; tt < t0; ++tt) if (tt >= 0) sum += bf1(U + (size_t)tt * PCOLS);
    for (int t = t0; t < t0 + 32; ++t) {
        const float ut = bf1(U + (size_t)t * PCOLS); sum += ut;
        const int cnt = (t + 1 < w) ? (t + 1) : w;
        pooled[((size_t)b * SEQ + t) * 512 + c] = (bf16)f2bf(sum / (float)cnt - ut);
        const int tl = t - w + 1; if (tl >= 0) sum -= bf1(U + (size_t)tl * PCOLS);
    }
}

__device__ __forceinline__ void conv_job(KP p, int l, int job, int tid, int wave, int lane, const bf16* P, bf16* ys, LAS unsigned char* lds) {
    const int b = job >> 7, t0 = (job & 127) * 16, c = tid;
    LAS float* Y = (LAS float*)lds;
    float v[46];
    const bf16* base = P + (size_t)b * SEQ * PCOLS + 1024 + c;
#pragma unroll
    for (int j = 0; j < 46; ++j) { const int tt = t0 - 30 + j; float x = 0.f; if (tt >= 0) { const float val = bf1(base + (size_t)tt * PCOLS), gate = bf1(base + (size_t)tt * PCOLS + 512); x = val * sigmoid_f(gate); } v[j] = x; }
    float y[16]; const float cb = p->in[15][l * 512 + c];
#pragma unroll
    for (int t = 0; t < 16; ++t) y[t] = cb;
#pragma unroll
    for (int k = 0; k < 31; ++k) { const float wk = p->in[14][(size_t)(l * 31 + k) * 512 + c];
#pragma unroll
        for (int t = 0; t < 16; ++t) y[t] = fmaf(wk, v[t + k], y[t]); }
#pragma unroll
    for (int t = 0; t < 16; ++t) Y[t * 512 + c] = y[t];
    __syncthreads();
#pragma unroll
    for (int q = 0; q < 2; ++q) { const int t = wave * 2 + q;
        const v4f a = *(const LAS v4f*)(Y + t * 512 + 8 * lane), bq = *(const LAS v4f*)(Y + t * 512 + 8 * lane + 4);
        float x[8] = {a.x, a.y, a.z, a.w, bq.x, bq.y, bq.z, bq.w};
        float s = 0.f;
#pragma unroll
        for (int i = 0; i < 8; ++i) s += x[i];
        const float mu = wave_sum(s, lane) * (1.f / 512.f); float s2 = 0.f;
#pragma unroll
        for (int i = 0; i < 8; ++i) { x[i] -= mu; s2 += x[i] * x[i]; }
        const float rstd = rsqrtf(wave_sum(s2, lane) * (1.f / 512.f) + EPS);
        const float* lg = p->in[16] + l * 512 + 8 * lane; const float* lb = p->in[17] + l * 512 + 8 * lane;
        float o[8];
#pragma unroll
        for (int i = 0; i < 8; ++i) { const float z = x[i] * rstd * lg[i] + lb[i]; o[i] = z * sigmoid_f(z); }
        v4u w; w.x = pk2(o[0], o[1]); w.y = pk2(o[2], o[3]); w.z = pk2(o[4], o[5]); w.w = pk2(o[6], o[7]);
        *(v4u*)(ys + ((size_t)b * SEQ + t0 + t) * DM + 1024 + 8 * lane) = w; }
    __syncthreads();
}

__device__ __forceinline__ void gmlp_job(KP p, int l, int job, int tid, int wave, int lane, const bf16* P, bf16* ys, LAS unsigned char* lds) {
    const int h = job & 3; const size_t row0 = (size_t)(job >> 2) * 128;
    LAS float* vn = (LAS float*)lds;
    for (int tt = 0; tt < 16; ++tt) { const int s = wave * 16 + tt;
        const v4u raw = *(const v4u*)(P + (row0 + s) * PCOLS + 2560 + 8 * lane);
        float x[8] = {bflo(raw.x), bfhi(raw.x), bflo(raw.y), bfhi(raw.y), bflo(raw.z), bfhi(raw.z), bflo(raw.w), bfhi(raw.w)};
        float sm = 0.f;
#pragma unroll
        for (int i = 0; i < 8; ++i) { x[i] = gelu_tanh(x[i]); sm += x[i]; }
        const float mu = wave_sum(sm, lane) * (1.f / 512.f); float s2 = 0.f;
#pragma unroll
        for (int i = 0; i < 8; ++i) { x[i] -= mu; s2 += x[i] * x[i]; }
        const float rstd = rsqrtf(wave_sum(s2, lane) * (1.f / 512.f) + EPS);
        if ((lane >> 4) == h) { const float* lg = p->in[18] + l * 512 + 8 * lane; const float* lb = p->in[19] + l * 512 + 8 * lane;
            v4f o0, o1;
#pragma unroll
            for (int i = 0; i < 4; ++i) { o0[i] = x[i] * rstd * lg[i] + lb[i]; o1[i] = x[4 + i] * rstd * lg[4 + i] + lb[4 + i]; }
            *(LAS v4f*)(vn + s * 128 + 8 * (lane & 15)) = o0; *(LAS v4f*)(vn + s * 128 + 8 * (lane & 15) + 4) = o1; } }
    __syncthreads();
    const int d = tid & 127, tg = __builtin_amdgcn_readfirstlane(tid >> 7);
    const float* Wsh = p->in[20] + (size_t)(l * 4 + h) * 128 * 128; const float* bs = p->in[21] + (l * 4 + h) * 128;
#pragma unroll 1
    for (int jj = 0; jj < 8; ++jj) {
        float acc[4] = {0.f, 0.f, 0.f, 0.f};
        const int tb = jj * 16 + tg, smax = tb + 12;
        for (int s4 = 0; s4 <= (smax >> 2); ++s4) { const int s = 4 * s4;
            const float v0 = vn[(s + 0) * 128 + d], v1 = vn[(s + 1) * 128 + d], v2 = vn[(s + 2) * 128 + d], v3 = vn[(s + 3) * 128 + d];
#pragma unroll
            for (int i = 0; i < 4; ++i) { const int t = tb + 4 * i; const v4f w = *(const v4f*)(Wsh + t * 128 + s);
                const float w0 = (s + 0 <= t) ? w.x : 0.f, w1 = (s + 1 <= t) ? w.y : 0.f, w2 = (s + 2 <= t) ? w.z : 0.f, w3 = (s + 3 <= t) ? w.w : 0.f;
                acc[i] += (w0 * v0 + w1 * v1) + (w2 * v2 + w3 * v3); } }
#pragma unroll
        for (int i = 0; i < 4; ++i) { const int t = tb + 4 * i; const float uu = gelu_tanh(bf1(P + (row0 + t) * PCOLS + 2048 + h * 128 + d));
            ys[(row0 + t) * DM + 1536 + h * 128 + d] = (bf16)f2bf(uu * (acc[i] + bs[t])); } }
    __syncthreads();
}

#ifndef PHMASK
#define PHMASK 0xFFFFFFFFu
#endif
#define PH_BEGIN() KP p = kargs(); int wave = wave_s; asm volatile("" : "+s"(wave)); int lane; asm volatile("v_mbcnt_lo_u32_b32 %0, -1, 0\n\tv_mbcnt_hi_u32_b32 %0, -1, %0" : "=v"(lane)); const int tid = wave * 64 + lane; \
    int bid = blockIdx.x, G = gridDim.x; asm volatile("" : "+s"(bid), "+s"(G)); const int gw = bid * NWAVES + wave, NGW = G * NWAVES; unsigned char* ws = p->ws; (void)lane; (void)gw; (void)NGW; (void)ws
__global__ void __launch_bounds__(NTHREADS, 2) hybrid_fwd(Params p_unused) {
    extern __shared__ __attribute__((aligned(16))) unsigned char lds_raw[];
    LAS unsigned char* lds = (LAS unsigned char*)lds_raw;
    cg::grid_group grid = cg::this_grid();
    const int wave_s = __builtin_amdgcn_readfirstlane((int)threadIdx.x >> 6);

    if (PHMASK & (1u << 0)) { PH_BEGIN();
        LAS float* scr = (LAS float*)(lds + wave * 16384);
        constexpr int I_IN = (DM / 64) * (INC / 32), I_FF1 = (DM / 64) * (DFF / 32), I_FF2 = (DFF / 64) * (DM / 32), I_SQ = (DM / 64) * (DM / 32), I_GLU = (512 / 64) * (1024 / 32);
        constexpr int PER_L = I_IN + I_FF1 + I_FF2 + 2 * I_SQ + I_GLU;
        for (int it = gw; it < DEPTH * PER_L; it += NGW) {
            const int l = it / PER_L; int r = it % PER_L;
            if (r < I_IN) { transpose_item(p->in[2] + (size_t)l * DM * INC, DM, INC, (bf16*)(ws + WS_WIN + l * L_WIN), scr, r, lane, 0); continue; } r -= I_IN;
            if (r < I_FF1) { transpose_item(p->in[26] + (size_t)l * DM * DFF, DM, DFF, (bf16*)(ws + WS_WFF1 + l * L_WFF), scr, r, lane, 0); continue; } r -= I_FF1;
            if (r < I_FF2) { transpose_item(p->in[27] + (size_t)l * DFF * DM, DFF, DM, (bf16*)(ws + WS_WFF2 + l * L_WFF), scr, r, lane, 0); continue; } r -= I_FF2;
            if (r < I_SQ) { transpose_item(p->in[23] + (size_t)l * DM * DM, DM, DM, (bf16*)(ws + WS_WO + l * L_WSQ), scr, r, lane, 0); continue; } r -= I_SQ;
            if (r < I_SQ) { transpose_item(p->in[22] + (size_t)l * DM * DM, DM, DM, (bf16*)(ws + WS_WBR + l * L_WSQ), scr, r, lane, 0); continue; } r -= I_SQ;
            transpose_item(p->in[11] + (size_t)l * 512 * 1024, 512, 1024, (bf16*)(ws + WS_WGLU + l * L_WGLU), scr, r, lane, 1);
        }
        for (int i = bid * NTHREADS + tid; i < DEPTH * 512 * 256; i += G * NTHREADS) { const int l = i / (512 * 256), r = i % (512 * 256), n = r >> 8, kk = r & 255, g = n >> 7, d = n & 127, cc = kk - 128 * (g & 1);
            const float v = (cc >= 0 && cc < 128) ? p->in[12][((size_t)(l * 4 + g) * 128 + cc) * 128 + d] : 0.f;
            ((bf16*)(ws + WS_WPOOL + l * L_WPOOL))[r] = (bf16)f2bf(v); }
        for (int m = gw; m < MTOK; m += NGW) rms_row_to_bf16(p->in[0] + (size_t)m * DM, p->in[1], (bf16*)(ws + WS_H) + (size_t)m * DM, lane);
    }
    grid.sync();

#pragma unroll 1
    for (int l = 0; l < DEPTH; ++l) {
        if (PHMASK & (1u << 1)) { PH_BEGIN();
          pg8::Gemm g{(const bf16*)(ws + WS_H), (const bf16*)(ws + WS_WIN + l * L_WIN), MTOK, INC, DM, DM, DM, 0}; pg8::StaticOrder S; S.init(MTOK, INC, G, bid);
          pg8::EpiBf16<0> E{(bf16*)(ws + WS_P), PCOLS, (bf16*)(ws + WS_G), 8192, nullptr, 0};
          pg8::gemm_phase<pg8::EpiBf16<0>, pg8::StaticOrder, true, true>(lds, g, S, E, wave, lane); }
        grid.sync();
        if (PHMASK & (1u << 2)) { PH_BEGIN();
          const bf16* Pb = (const bf16*)(ws + WS_P); bf16* YS = (bf16*)(ws + WS_YS);
          for (int j = bid; j < 256 + 512 + 512 + 256; j += G) {
            if (j < 256) gmlp_job(p, l, j, tid, wave, lane, Pb, YS, lds);
            else if (j < 768) ssm_pass1_job(p, l, j - 256, wave, lane, Pb, (float*)(ws + WS_SEND));
            else if (j < 1280) conv_job(p, l, j - 768, tid, wave, lane, Pb, YS, lds);
            else pool_job(j - 1280, tid, Pb, (bf16*)(ws + WS_POOLED));
          } }
        grid.sync();
        if (PHMASK & (1u << 3)) { PH_BEGIN();
          for (int j = bid; j < 512; j += G) ssm_pass2_job(p, l, j, tid, wave, lane, (const bf16*)(ws + WS_P), (const float*)(ws + WS_SEND), (bf16*)(ws + WS_Z), lds); }
        grid.sync();
        if (PHMASK & (1u << 4)) { PH_BEGIN();
          const bool split = (G >= 192);
          pg8::Gemm g{(const bf16*)(ws + WS_Z), (const bf16*)(ws + WS_WGLU + l * L_WGLU), MTOK, 1024, 512, 512, 512, 0}; pg8::StaticOrder S; S.init(MTOK, 1024, split ? 128 : G, split ? (bid < 128 ? bid : -1) : bid);
          pg8::EpiGlu E{(bf16*)(ws + WS_YS), DM};
          pg8::gemm_phase<pg8::EpiGlu, pg8::StaticOrder, true, true>(lds, g, S, E, wave, lane); }
        if (PHMASK & (1u << 4)) { PH_BEGIN();
          const bool split = (G >= 192);
          pg8::Gemm g{(const bf16*)(ws + WS_POOLED), (const bf16*)(ws + WS_WPOOL + l * L_WPOOL), MTOK, 512, 256, 512, 256, 256}; pg8::StaticOrder S; S.init(MTOK, 512, split ? 64 : G, split ? ((bid >= 128 && bid < 192) ? bid - 128 : -1) : bid);
          pg8::EpiBf16<2> E{(bf16*)(ws + WS_YS), DM, nullptr, 0, p->in[13] + l * 512, 512};
          pg8::gemm_phase<pg8::EpiBf16<2>, pg8::StaticOrder, true, true>(lds, g, S, E, wave, lane); }
        grid.sync();
        if (PHMASK & (1u << 5)) { PH_BEGIN();
          pg8::Gemm g{(const bf16*)(ws + WS_YS), (const bf16*)(ws + WS_WBR + l * L_WSQ), MTOK, DM, 512, DM, DM, 0}; pg8::SegOrder S; S.init(MTOK, DM, G, bid);
          pg8::EpiBranch E{(bf16*)(ws + WS_MERGED), DM, (const bf16*)(ws + WS_G)};
          pg8::gemm_phase<pg8::EpiBranch, pg8::SegOrder, true, true>(lds, g, S, E, wave, lane); }
        grid.sync();
        if (PHMASK & (1u << 6)) { PH_BEGIN();
          pg8::Gemm g{(const bf16*)(ws + WS_MERGED), (const bf16*)(ws + WS_WO + l * L_WSQ), MTOK, DM, DM, DM, DM, 0}; pg8::StaticOrder S; S.init(MTOK, DM, G, bid);
          pg8::EpiF32 E{(float*)(ws + WS_MIX), DM};
          pg8::gemm_phase<pg8::EpiF32, pg8::StaticOrder, true, true>(lds, g, S, E, wave, lane); }
        grid.sync();
        if (PHMASK & (1u << 7)) { PH_BEGIN();
          const float* xin = (l == 0) ? p->in[0] : p->out; float* xo = p->out; const float* MIX = (const float*)(ws + WS_MIX); bf16* Hb = (bf16*)(ws + WS_H);
          for (int m = gw; m < MTOK; m += NGW) resid_norm_row(MIX + (size_t)m * DM, xin + (size_t)m * DM, xo + (size_t)m * DM, p->in[24] + l * DM, p->in[25] + l * DM, Hb + (size_t)m * DM, lane); }
        grid.sync();
        if (PHMASK & (1u << 8)) { PH_BEGIN();
          pg8::Gemm g{(const bf16*)(ws + WS_H), (const bf16*)(ws + WS_WFF1 + l * L_WFF), MTOK, DFF, DM, DM, DM, 0}; pg8::StaticOrder S; S.init(MTOK, DFF, G, bid);
          pg8::EpiBf16<1> E{(bf16*)(ws + WS_G), DFF, nullptr, 0, nullptr, 0};
          pg8::gemm_phase<pg8::EpiBf16<1>, pg8::StaticOrder, true, true>(lds, g, S, E, wave, lane); }
        grid.sync();
        if (PHMASK & (1u << 9)) { PH_BEGIN();
          pg8::Gemm g{(const bf16*)(ws + WS_G), (const bf16*)(ws + WS_WFF2 + l * L_WFF), MTOK, DM, DFF, DFF, DFF, 0}; pg8::StaticOrder S; S.init(MTOK, DM, G, bid);
          pg8::EpiF32 E{(float*)(ws + WS_MIX), DM};
          pg8::gemm_phase<pg8::EpiF32, pg8::StaticOrder, true, true>(lds, g, S, E, wave, lane); }
        grid.sync();
        if (PHMASK & (1u << 10)) { PH_BEGIN();
          const bool more = (l + 1 < DEPTH); float* xo = p->out; const float* MIX = (const float*)(ws + WS_MIX); bf16* Hb = (bf16*)(ws + WS_H);
          for (int m = gw; m < MTOK; m += NGW) resid_norm_row(MIX + (size_t)m * DM, xo + (size_t)m * DM, xo + (size_t)m * DM, p->in[28] + l * DM, more ? p->in[1] + (l + 1) * DM : nullptr, more ? Hb + (size_t)m * DM : nullptr, lane); }
        if (l + 1 < DEPTH) grid.sync();
    }
}

extern "C" void kernel_launch(void* const* d_in, const int* in_sizes, int n_in, void* d_out, int out_size, void* d_ws, size_t ws_size, hipStream_t stream) {
    static int grid = 0;
    if (grid == 0) {
        if (n_in != 29 || out_size != MTOK * DM || ws_size < WS_END) { fprintf(stderr, "kernel_launch: unexpected shapes (n_in %d, out %d, ws %zu < %zu)\n", n_in, out_size, ws_size, (size_t)WS_END); grid = -1; return; }
        int dev = 0, cus = 0, per_cu = 0;
        if (hipGetDevice(&dev) != hipSuccess || hipDeviceGetAttribute(&cus, hipDeviceAttributeMultiprocessorCount, dev) != hipSuccess) { grid = -1; return; }
        if (hipFuncSetAttribute((const void*)hybrid_fwd, hipFuncAttributeMaxDynamicSharedMemorySize, LDS_BYTES) != hipSuccess) { fprintf(stderr, "kernel_launch: hipFuncSetAttribute failed\n"); grid = -1; return; }
        if (hipOccupancyMaxActiveBlocksPerMultiprocessor(&per_cu, (const void*)hybrid_fwd, NTHREADS, LDS_BYTES) != hipSuccess || per_cu < 1) { fprintf(stderr, "kernel_launch: occupancy query says %d blocks/CU\n", per_cu); (void)hipGetLastError(); grid = -1; return; }
        grid = cus * per_cu; if (grid > 256) grid = 256;
    }
    if (grid < 0) return;
    Params p{};
    for (int i = 0; i < 29; ++i) p.in[i] = (const float*)d_in[i];
    p.out = (float*)d_out; p.ws = (unsigned char*)d_ws;
    void* args[] = {&p};
    hipError_t e = hipLaunchCooperativeKernel((const void*)hybrid_fwd, dim3(grid), dim3(NTHREADS), args, LDS_BYTES, stream);
    if (e != hipSuccess) fprintf(stderr, "cooperative launch failed: %s (grid %d)\n", hipGetErrorString(e), grid);
}
```

```cpp
#include <hip/hip_runtime.h>
#include <hip/hip_cooperative_groups.h>
#include <cstdio>
#include <cstdint>
namespace cg = cooperative_groups;

namespace pg8 {
#define PG8_LAS __attribute__((address_space(3)))
typedef unsigned short bf16_t;
typedef short bf16x8 __attribute__((ext_vector_type(8)));
typedef float f32x4 __attribute__((ext_vector_type(4)));
typedef unsigned u32x4 __attribute__((ext_vector_type(4)));
typedef unsigned u32x2 __attribute__((ext_vector_type(2)));
constexpr int BM = 256, BK = 64, HALF = 128, HTB = HALF * BK * 2  , STAGE_BYTES = 8 * HTB, NXCD = 8, WGM = 8;

__host__ __device__ __forceinline__ int lds_byte(int r, int c) { const int st = (r >> 4) * 2 + (c >> 5), rr = r & 15, cc = c & 31, ob = rr * 64 + cc * 2; return st * 1024 + (ob ^ (((ob >> 9) & 1) << 5)); }
__host__ __device__ __forceinline__ void stage_rc(int b, int& R, int& C) { const int st = b / 1024, sb = b % 1024, swz = sb ^ (((sb >> 9) & 1) << 5); R = (st >> 1) * 16 + swz / 64; C = (st & 1) * 32 + (swz % 64) / 2; }
__host__ __device__ __forceinline__ int perm32(int rho) { const int n = rho >> 4, i = rho & 15; return 8 * (i >> 2) + 4 * n + (i & 3); }

struct Unit { int pm, pn, seg; };
struct Gemm { const bf16_t* A; const bf16_t* Bt; int M, N, K, lda, ldb, a_pn_off; };

struct StaticOrder {
    int nM, nN, nwg, G, c, reps;
    __host__ __device__ void init(int M, int N, int G_, int c_) { nM = M / BM; nN = N / BM; nwg = nM * nN; G = G_; c = c_; reps = 1; }
    __host__ __device__ bool next(int i, Unit& u) const {
        if (c < 0 || c >= nwg) return false; { const int nc = (nwg - c + G - 1) / G; if (i >= reps * nc) return false; i = i % nc; }
        const long L = (long)i * G + c;
        int wgid = (int)L; { const int q = nwg / NXCD, r = nwg % NXCD, xcd = wgid % NXCD, off = wgid / NXCD; wgid = (xcd < r ? xcd * (q + 1) : r * (q + 1) + (xcd - r) * q) + off; }
        const int nig = WGM * nN, gid = wgid / nig, fm = gid * WGM, gsz = (nM - fm) < WGM ? (nM - fm) : WGM;
        u.pm = fm + ((wgid % nig) % gsz); u.pn = (wgid % nig) / gsz; u.seg = 0; return true;
    }
    __device__ __forceinline__ void a_ready(const Unit&) const {}
    __device__ __forceinline__ void done(const Unit&) const {}
};
struct SegOrder : StaticOrder {
    __host__ __device__ bool next(int i, Unit& u) const { if (!StaticOrder::next(i >> 2, u)) return false; u.seg = i & 3; return true; }
};

__device__ __forceinline__ unsigned cvt_pk_bf16(float lo, float hi) { unsigned r; asm volatile("v_cvt_pk_bf16_f32 %0, %1, %2" : "=v"(r) : "v"(lo), "v"(hi)); return r; }
__device__ __forceinline__ float bf_lo(unsigned w) { return __uint_as_float(w << 16); }
__device__ __forceinline__ float bf_hi(unsigned w) { return __uint_as_float(w & 0xffff0000u); }
__device__ __forceinline__ float sigm(float x) { return __builtin_amdgcn_rcpf(1.0f + __expf(-x)); }

struct EpiF32 {
    static constexpr bool PERM = false, AFTER_DRAIN = false, KHOOK = false;
    float* C; int ldc;
    __device__ __forceinline__ void operator()(f32x4 (&acc)[2][2][4][2], const Unit& u, int wr, int wc, int fr, int fq) const {
        const int row0 = u.pm * BM + wr * 64 + fr, col0 = u.pn * BM + wc * 32 + 4 * fq;
#pragma unroll
        for (int ai = 0; ai < 2; ++ai)
#pragma unroll
            for (int m = 0; m < 4; ++m) { float* rowp = C + (size_t)(row0 + ai * HALF + m * 16) * ldc + col0;
#pragma unroll
                for (int bj = 0; bj < 2; ++bj)
#pragma unroll
                    for (int n = 0; n < 2; ++n) *(f32x4*)(rowp + bj * HALF + n * 16) = acc[ai][bj][m][n]; }
    }
};
template <int ACT> struct EpiBf16 {
    static constexpr bool PERM = true, AFTER_DRAIN = false, KHOOK = false;
    bf16_t* O; int ldc; bf16_t* O2; int ldc2; const float* scale; int coff;
    __device__ __forceinline__ void operator()(f32x4 (&acc)[2][2][4][2], const Unit& u, int wr, int wc, int fr, int fq) const {
        const int row0 = u.pm * BM + wr * 64 + fr; int colt = u.pn * BM; bf16_t* base = O; int ld = ldc; bool sg = false;
        if (ACT == 0 && u.pn >= 12) { base = O2; ld = ldc2; colt -= 12 * BM; sg = true; }
        const int col0 = colt + wc * 32 + 8 * fq + (ACT == 2 ? coff : 0), scol0 = u.pn * BM + wc * 32 + 8 * fq;
#pragma unroll
        for (int ai = 0; ai < 2; ++ai)
#pragma unroll
            for (int m = 0; m < 4; ++m) { bf16_t* rowp = base + (size_t)(row0 + ai * HALF + m * 16) * ld + col0;
#pragma unroll
                for (int bj = 0; bj < 2; ++bj) { f32x4 v0 = acc[ai][bj][m][0], v1 = acc[ai][bj][m][1];
                    if (ACT == 0) { if (sg) {
#pragma unroll
                        for (int j = 0; j < 4; ++j) { v0[j] = sigm(fmaxf(v0[j], -30.f)); v1[j] = sigm(fmaxf(v1[j], -30.f)); } } }
                    if (ACT == 1) {
#pragma unroll
                        for (int j = 0; j < 4; ++j) { const float a = fmaxf(v0[j], 0.f), b = fmaxf(v1[j], 0.f); v0[j] = a * a; v1[j] = b * b; } }
                    if (ACT == 2) { const f32x4 s0 = *(const f32x4*)(scale + scol0 + bj * HALF), s1 = *(const f32x4*)(scale + scol0 + bj * HALF + 4); v0 = v0 * s0; v1 = v1 * s1; }
                    u32x4 w; w.x = cvt_pk_bf16(v0[0], v0[1]); w.y = cvt_pk_bf16(v0[2], v0[3]); w.z = cvt_pk_bf16(v1[0], v1[1]); w.w = cvt_pk_bf16(v1[2], v1[3]);
                    *(u32x4*)(rowp + bj * HALF) = w; } }
    }
};
struct EpiGlu {
    static constexpr bool PERM = true, AFTER_DRAIN = false, KHOOK = false;
    bf16_t* O; int ldc;
    __device__ __forceinline__ void operator()(f32x4 (&acc)[2][2][4][2], const Unit& u, int wr, int wc, int fr, int fq) const {
        const int row0 = u.pm * BM + wr * 64 + fr, col0 = u.pn * HALF + wc * 32 + 8 * fq;
#pragma unroll
        for (int ai = 0; ai < 2; ++ai)
#pragma unroll
            for (int m = 0; m < 4; ++m) { bf16_t* rowp = O + (size_t)(row0 + ai * HALF + m * 16) * ldc + col0;
                f32x4 v0 = acc[ai][0][m][0], v1 = acc[ai][0][m][1]; const f32x4 g0 = acc[ai][1][m][0], g1 = acc[ai][1][m][1];
#pragma unroll
                for (int j = 0; j < 4; ++j) { v0[j] *= sigm(g0[j]); v1[j] *= sigm(g1[j]); }
                u32x4 w; w.x = cvt_pk_bf16(v0[0], v0[1]); w.y = cvt_pk_bf16(v0[2], v0[3]); w.z = cvt_pk_bf16(v1[0], v1[1]); w.w = cvt_pk_bf16(v1[2], v1[3]);
                *(u32x4*)rowp = w; }
    }
};
struct EpiBranch {
    static constexpr bool PERM = true, AFTER_DRAIN = false, KHOOK = true;
    bf16_t* O; int ldc; const bf16_t* Gt;
    __device__ __forceinline__ void khook(f32x4 (&acc)[2][2][4][2], const Unit& u, int seg, int wr, int wc, int fr, int fq) const {
        int row0 = u.pm * BM + wr * 64 + fr, col0 = u.pn * BM + wc * 32 + 8 * fq;
        asm volatile("" : "+v"(row0), "+v"(col0));
        const bool lastseg = (seg >= 3); const int nxt = lastseg ? 0 : 2048;
#pragma unroll
        for (int ai = 0; ai < 2; ++ai)
#pragma unroll
            for (int m = 0; m < 4; ++m) {
#pragma unroll
                for (int bj = 0; bj < 2; ++bj) { const bf16_t* gp = Gt + (size_t)(row0 + ai * HALF + m * 16) * 8192 + seg * 2048 + col0 + bj * HALF;
                    const u32x4 a = *(const u32x4*)gp; const u32x4 b = *(const u32x4*)(gp + nxt);
                    f32x4 r0 = (f32x4){bf_lo(a.x), bf_hi(a.x), bf_lo(a.y), bf_hi(a.y)}, r1 = (f32x4){bf_lo(a.z), bf_hi(a.z), bf_lo(a.w), bf_hi(a.w)};
                    f32x4 q0 = (f32x4){bf_lo(b.x), bf_hi(b.x), bf_lo(b.y), bf_hi(b.y)}, q1 = (f32x4){bf_lo(b.z), bf_hi(b.z), bf_lo(b.w), bf_hi(b.w)};
#pragma unroll
                    for (int j = 0; j < 4; ++j) { q0[j] = lastseg ? 1.0f : __builtin_amdgcn_rcpf(q0[j]); q1[j] = lastseg ? 1.0f : __builtin_amdgcn_rcpf(q1[j]); }
                    acc[ai][bj][m][0] = acc[ai][bj][m][0] * (r0 * q0); acc[ai][bj][m][1] = acc[ai][bj][m][1] * (r1 * q1); }
                asm volatile("" ::: "memory"); }
    }
    __device__ __forceinline__ void operator()(f32x4 (&acc)[2][2][4][2], const Unit& u, int wr, int wc, int fr, int fq) const {
        khook(acc, u, u.seg, wr, wc, fr, fq);
        if (u.seg != 3) return;
        const int row0 = u.pm * BM + wr * 64 + fr, col0 = u.pn * BM + wc * 32 + 8 * fq;
#pragma unroll
        for (int ai = 0; ai < 2; ++ai)
#pragma unroll
            for (int m = 0; m < 4; ++m) { bf16_t* rowp = O + (size_t)(row0 + ai * HALF + m * 16) * ldc + col0;
#pragma unroll
                for (int bj = 0; bj < 2; ++bj) { const f32x4 v0 = acc[ai][bj][m][0], v1 = acc[ai][bj][m][1];
                    u32x4 w; w.x = cvt_pk_bf16(v0[0], v0[1]); w.y = cvt_pk_bf16(v0[2], v0[3]); w.z = cvt_pk_bf16(v1[0], v1[1]); w.w = cvt_pk_bf16(v1[2], v1[3]);
                    *(u32x4*)(rowp + bj * HALF) = w; } }
    }
};
template <class Epi, class Sched, bool ALIGN_EPI = false, bool SP2 = false>
__device__ __forceinline__ void gemm_phase(PG8_LAS unsigned char* lds, const Gemm g, const Sched& S, const Epi& E, const int wave_in, const int lane_in) {
    int tid = wave_in * 64 + lane_in; asm volatile("" : "+v"(tid));
    const int wid = wave_in, lane = tid & 63, wr = wid >> 2, wc = wid & 3, fr = lane & 15, fq = lane >> 4;
    const int K = g.K, nt = K / BK;
    unsigned voffA[2], voffB[2];
#pragma unroll
    for (int i = 0; i < 2; ++i) { int R, C; stage_rc(tid * 16 + i * 8192, R, C); const int Rb = Epi::PERM ? ((R & ~31) + perm32(R & 31)) : R;
        voffA[i] = (unsigned)(R * g.lda + C) * 2u; voffB[i] = (unsigned)(Rb * g.ldb + C) * 2u; }
    constexpr unsigned kstep = BK * 2;
    const unsigned hstepA = (unsigned)HALF * g.lda * 2u, hstepB = (unsigned)HALF * g.ldb * 2u;
    const unsigned tstepA = 2u * hstepA, tstepB = 2u * hstepB;
    const unsigned pnoff = (unsigned)g.a_pn_off * 2u;
    const unsigned ldsw = (unsigned)wid * 1024u;
    const int aoff = lds_byte(wr * 64 + fr, fq * 8), boff = lds_byte(wc * 32 + fr, fq * 8);
#define PG8_SA(b, h) (((b) * 2 + (h)) * HTB)
#define PG8_SB(b, h) ((4 + (b) * 2 + (h)) * HTB)
#define PG8_STAGE(bufoff, gbase, voff) do { _Pragma("unroll") for (int _i = 0; _i < 2; ++_i) \
        __builtin_amdgcn_global_load_lds((const unsigned*)((const char*)(gbase) + (voff)[_i]), (PG8_LAS unsigned*)(lds + (bufoff) + ldsw + _i * 8192), 16, 0, 0); } while (0)
#define PG8_LDA(dst, b, h) do { _Pragma("unroll") for (int m = 0; m < 4; ++m) _Pragma("unroll") for (int k = 0; k < 2; ++k) dst[m][k] = *(const PG8_LAS bf16x8*)(lds + PG8_SA(b, h) + aoff + m * 2048 + k * 1024); } while (0)
#define PG8_LDB(dst, b, h) do { _Pragma("unroll") for (int n = 0; n < 2; ++n) _Pragma("unroll") for (int k = 0; k < 2; ++k) dst[n][k] = *(const PG8_LAS bf16x8*)(lds + PG8_SB(b, h) + boff + n * 2048 + k * 1024); } while (0)
#define PG8_MMA(ai, bj, At, Bt) do { __builtin_amdgcn_s_setprio(1); _Pragma("unroll") for (int m = 0; m < 4; ++m) _Pragma("unroll") for (int n = 0; n < 2; ++n) _Pragma("unroll") for (int k = 0; k < 2; ++k) \
        acc[ai][bj][m][n] = __builtin_amdgcn_mfma_f32_16x16x32_bf16(Bt[n][k], At[m][k], acc[ai][bj][m][n], 0, 0, 0); __builtin_amdgcn_s_setprio(0); } while (0)
#define PG8_WAIT_V(n) asm volatile("s_waitcnt vmcnt(" #n ")" ::: "memory")
#define PG8_WAIT_L(n) asm volatile("s_waitcnt lgkmcnt(" #n ")" ::: "memory")
#define PG8_BAR __builtin_amdgcn_s_barrier()
#define PG8_SCHED __builtin_amdgcn_sched_barrier(0)
    Unit cur, nxt; int ui = 0;
    if (!S.next(0, cur)) return;
    f32x4 acc[2][2][4][2];
#pragma unroll
    for (int a = 0; a < 2; ++a)
#pragma unroll
        for (int b = 0; b < 2; ++b)
#pragma unroll
            for (int m = 0; m < 4; ++m)
#pragma unroll
                for (int n = 0; n < 2; ++n) acc[a][b][m][n] = (f32x4){0.f, 0.f, 0.f, 0.f};
    bf16x8 At[4][2], B0[2][2], B1[2][2];
    const unsigned segoff = Epi::KHOOK ? (unsigned)K * 2u : 0u;
    const char* cA = (const char*)g.A + ((unsigned)cur.pm * tstepA + (unsigned)cur.pn * pnoff + (unsigned)cur.seg * segoff); const char* cB = (const char*)g.Bt + ((unsigned)cur.pn * tstepB + (unsigned)cur.seg * segoff);
    S.a_ready(cur);
    if constexpr (SP2) {
        PG8_STAGE(PG8_SB(0, 0), cB, voffB); PG8_STAGE(PG8_SB(0, 1), cB + hstepB, voffB); PG8_STAGE(PG8_SA(0, 0), cA, voffA); PG8_STAGE(PG8_SA(0, 1), cA + hstepA, voffA);
        if (wr == 1) PG8_BAR;
        PG8_WAIT_V(2); PG8_BAR;
        PG8_STAGE(PG8_SB(1, 0), cB + kstep, voffB); PG8_STAGE(PG8_SA(1, 0), cA + kstep, voffA); PG8_STAGE(PG8_SB(1, 1), cB + hstepB + kstep, voffB);
        PG8_WAIT_V(6); PG8_BAR;
    } else {
        PG8_STAGE(PG8_SB(0, 0), cB, voffB); PG8_STAGE(PG8_SA(0, 0), cA, voffA); PG8_STAGE(PG8_SB(0, 1), cB + hstepB, voffB); PG8_STAGE(PG8_SA(0, 1), cA + hstepA, voffA);
        if (wr == 1) PG8_BAR;
        PG8_WAIT_V(4); PG8_BAR;
        PG8_STAGE(PG8_SB(1, 0), cB + kstep, voffB); PG8_STAGE(PG8_SA(1, 0), cA + kstep, voffA); PG8_STAGE(PG8_SB(1, 1), cB + hstepB + kstep, voffB);
        PG8_WAIT_V(6); PG8_BAR;
    }
    for (;;) {
        const bool has_next = S.next(ui + 1, nxt);
        const char* nA = has_next ? (const char*)g.A + ((unsigned)nxt.pm * tstepA + (unsigned)nxt.pn * pnoff + (unsigned)nxt.seg * segoff) : cA; const char* nB = has_next ? (const char*)g.Bt + ((unsigned)nxt.pn * tstepB + (unsigned)nxt.seg * segoff) : cB;
        for (int t = 0; t < nt; t += 2) {
            const bool last = (t == nt - 2);
            const char* a1 = cA + (unsigned)(t + 1) * kstep;
            const char* a2 = last ? nA : cA + (unsigned)(t + 2) * kstep; const char* b2 = last ? nB : cB + (unsigned)(t + 2) * kstep;
            const char* a3 = a2 + kstep; const char* b3 = b2 + kstep;
            if (last && has_next) S.a_ready(nxt);
            if constexpr (SP2) {
            PG8_LDB(B0, 0, 0); PG8_LDB(B1, 0, 1); PG8_SCHED; PG8_LDA(At, 0, 0); PG8_STAGE(PG8_SA(1, 1), a1 + hstepA, voffA);
            PG8_WAIT_V(8); PG8_WAIT_L(0); PG8_BAR; PG8_MMA(0, 0, At, B0); PG8_MMA(0, 1, At, B1); PG8_BAR; PG8_SCHED;
            PG8_LDA(At, 0, 1); PG8_STAGE(PG8_SB(0, 0), b2, voffB); PG8_STAGE(PG8_SB(0, 1), b2 + hstepB, voffB); PG8_STAGE(PG8_SA(0, 0), a2, voffA);
            PG8_WAIT_V(8); PG8_WAIT_L(0); PG8_BAR; PG8_MMA(1, 0, At, B0); PG8_MMA(1, 1, At, B1); PG8_BAR; PG8_SCHED;
            PG8_LDB(B0, 1, 0); PG8_LDB(B1, 1, 1); PG8_SCHED; PG8_LDA(At, 1, 0); PG8_STAGE(PG8_SA(0, 1), a2 + hstepA, voffA);
            PG8_WAIT_V(8); PG8_WAIT_L(0); PG8_BAR; PG8_MMA(0, 0, At, B0); PG8_MMA(0, 1, At, B1); PG8_BAR; PG8_SCHED;
            PG8_LDA(At, 1, 1); PG8_STAGE(PG8_SB(1, 0), b3, voffB); PG8_STAGE(PG8_SB(1, 1), b3 + hstepB, voffB); PG8_STAGE(PG8_SA(1, 0), a3, voffA);
            PG8_WAIT_V(8); PG8_WAIT_L(0); PG8_BAR; PG8_MMA(1, 0, At, B0); PG8_MMA(1, 1, At, B1); PG8_BAR; PG8_SCHED;
            } else {
            PG8_LDB(B0, 0, 0); PG8_SCHED; PG8_LDA(At, 0, 0); PG8_STAGE(PG8_SA(1, 1), a1 + hstepA, voffA);
            PG8_WAIT_L(8); PG8_BAR; PG8_WAIT_L(0); PG8_MMA(0, 0, At, B0); PG8_BAR; PG8_SCHED;
            PG8_LDB(B1, 0, 1); PG8_STAGE(PG8_SB(0, 0), b2, voffB);
            PG8_BAR; PG8_WAIT_L(0); PG8_MMA(0, 1, At, B1); PG8_BAR;
            PG8_LDA(At, 0, 1); PG8_STAGE(PG8_SA(0, 0), a2, voffA);
            PG8_BAR; PG8_WAIT_L(0); PG8_MMA(1, 0, At, B0); PG8_BAR; PG8_SCHED;
            PG8_STAGE(PG8_SB(0, 1), b2 + hstepB, voffB);
            PG8_WAIT_V(6); PG8_BAR; PG8_MMA(1, 1, At, B1); PG8_BAR;
            PG8_LDB(B0, 1, 0); PG8_SCHED; PG8_LDA(At, 1, 0); PG8_STAGE(PG8_SA(0, 1), a2 + hstepA, voffA);
            PG8_WAIT_L(8); PG8_BAR; PG8_WAIT_L(0); PG8_MMA(0, 0, At, B0); PG8_BAR; PG8_SCHED;
            PG8_LDB(B1, 1, 1); PG8_STAGE(PG8_SB(1, 0), b3, voffB);
            PG8_BAR; PG8_WAIT_L(0); PG8_MMA(0, 1, At, B1); PG8_BAR;
            PG8_LDA(At, 1, 1); PG8_STAGE(PG8_SA(1, 0), a3, voffA);
            PG8_BAR; PG8_WAIT_L(0); PG8_MMA(1, 0, At, B0); PG8_BAR; PG8_SCHED;
            PG8_STAGE(PG8_SB(1, 1), b3 + hstepB, voffB);
            PG8_WAIT_V(6); PG8_BAR; PG8_MMA(1, 1, At, B1); PG8_BAR;
            }
        }
        if constexpr (ALIGN_EPI) { if (wr == 0) PG8_BAR; }
        if constexpr (!Epi::AFTER_DRAIN) { int l2; asm volatile("v_mbcnt_lo_u32_b32 %0, -1, 0\n\tv_mbcnt_hi_u32_b32 %0, -1, %0" : "=v"(l2)); E(acc, cur, wr, wc, l2 & 15, l2 >> 4); S.done(cur); }
        if (!has_next) break;
        if (!Epi::KHOOK || cur.seg == 3)
#pragma unroll
        for (int a = 0; a < 2; ++a)
#pragma unroll
            for (int b = 0; b < 2; ++b)
#pragma unroll
                for (int m = 0; m < 4; ++m)
#pragma unroll
                    for (int n = 0; n < 2; ++n) acc[a][b][m][n] = (f32x4){0.f, 0.f, 0.f, 0.f};
        cur = nxt; cA = nA; cB = nB; ++ui;
        if constexpr (ALIGN_EPI) { if (wr == 1) PG8_BAR; }
    }
    PG8_WAIT_V(0);
    if constexpr (!ALIGN_EPI) { if (wr == 0) PG8_BAR; }
    PG8_BAR;
    if constexpr (Epi::AFTER_DRAIN) { E.fused(acc, cur, wr, wc, fr, fq, lds, wid, lane); S.done(cur); }
#undef PG8_SA
#undef PG8_SB
#undef PG8_STAGE
#undef PG8_LDA
#undef PG8_LDB
#undef PG8_MMA
#undef PG8_WAIT_V
#undef PG8_WAIT_L
#undef PG8_BAR
#undef PG8_SCHED
}
}

constexpr int DM = 2048, NB = 4, SEQ = 2048, MTOK = NB * SEQ, DEPTH = 2;
constexpr int WBR = 512, INC = 11264, PCOLS = 3072, DFF = 8192;
constexpr float EPS = 1e-6f;
constexpr int NTHREADS = 512, NWAVES = 8;
constexpr int LDS_BYTES = 147456, LDS_ST_OFF = 147392;

constexpr size_t MiB = (size_t)1 << 20;
constexpr size_t WS_WIN = 0, WS_WFF1 = 88 * MiB, WS_WFF2 = 152 * MiB, WS_WO = 216 * MiB, WS_WBR = 232 * MiB, WS_WGLU = 248 * MiB, WS_WPOOL = 250 * MiB, WS_SEND = 251 * MiB;
constexpr size_t WS_BAR = 253 * MiB;
constexpr size_t WS_H = 254 * MiB, WS_P = 286 * MiB, WS_G = 334 * MiB, WS_YS = 462 * MiB, WS_Z = 494 * MiB, WS_POOLED = 502 * MiB, WS_MERGED = 510 * MiB, WS_MIX = 542 * MiB, WS_END = 606 * MiB;
constexpr size_t L_WIN = (size_t)INC * DM * 2, L_WFF = (size_t)DFF * DM * 2, L_WSQ = (size_t)DM * DM * 2, L_WGLU = (size_t)1024 * 512 * 2, L_WPOOL = (size_t)512 * 256 * 2;

typedef unsigned short bf16;
#define LAS __attribute__((address_space(3)))
typedef unsigned v4u __attribute__((ext_vector_type(4)));
typedef unsigned v2u __attribute__((ext_vector_type(2)));
typedef float v4f __attribute__((ext_vector_type(4)));
typedef float v2f __attribute__((ext_vector_type(2)));

struct Params { const float* in[29]; float* out; unsigned char* ws; };
typedef const Params __attribute__((address_space(4)))* KP;
__device__ __forceinline__ KP kargs() { KP q = (KP)__builtin_amdgcn_kernarg_segment_ptr(); asm volatile("" : "+s"(q)); return q; }

__device__ __forceinline__ unsigned f2bf(float f) { unsigned u = __float_as_uint(f); return (u + 0x7fffu + ((u >> 16) & 1u)) >> 16; }
__device__ __forceinline__ unsigned pk2(float lo, float hi) { return f2bf(lo) | (f2bf(hi) << 16); }
__device__ __forceinline__ float bflo(unsigned w) { return __uint_as_float(w << 16); }
__device__ __forceinline__ float bfhi(unsigned w) { return __uint_as_float(w & 0xffff0000u); }
__device__ __forceinline__ float bf1(const bf16* p) { return __uint_as_float(((unsigned)*p) << 16); }
__device__ __forceinline__ float sigmoid_f(float x) { return 1.0f / (1.0f + __expf(-x)); }
__device__ __forceinline__ float gelu_tanh(float x) { const float y = 1.5957691216057308f * (x + 0.044715f * x * x * x); return x / (1.0f + __expf(-y)); }
__device__ __forceinline__ float wave_sum(float v, int lane) {
#pragma unroll
    for (int o = 1; o < 64; o <<= 1) v += __builtin_bit_cast(float, __builtin_amdgcn_ds_bpermute((lane ^ o) << 2, __builtin_bit_cast(int, v)));
    return v;
}
#define LDS_WAIT() asm volatile("s_waitcnt lgkmcnt(0)" ::: "memory")

__device__ __forceinline__ void transpose_item(const float* W, int K, int N, bf16* WT, LAS float* scr, int item, int lane, int mode) {
    const int nblk = N / 32, kb = item / nblk, nb = item % nblk, k0 = 64 * kb, n0 = 32 * nb;
    int src0 = n0; if (mode == 1) { const int pn = n0 >> 8, bj = (n0 >> 7) & 1, j0 = n0 & 127; src0 = bj * 512 + pn * 128 + j0; }
#pragma unroll 8
    for (int i = 0; i < 32; ++i) { const int kk = 2 * i + (lane >> 5); scr[kk * 33 + (lane & 31)] = W[(size_t)(k0 + kk) * N + src0 + (lane & 31)]; }
    LDS_WAIT();
    const int c = lane & 7;
#pragma unroll
    for (int j = 0; j < 4; ++j) { const int n = (lane >> 3) + 8 * j; const LAS float* s = scr + (8 * c) * 33 + n;
        v4u o; o.x = pk2(s[0 * 33], s[1 * 33]); o.y = pk2(s[2 * 33], s[3 * 33]); o.z = pk2(s[4 * 33], s[5 * 33]); o.w = pk2(s[6 * 33], s[7 * 33]);
        *(v4u*)(WT + (size_t)(n0 + n) * K + k0 + 8 * c) = o; }
    LDS_WAIT();
}

__device__ __forceinline__ void rms_row_to_bf16(const float* xrow, const float* g, bf16* orow, int lane) {
    const v4f* xr = (const v4f*)xrow + lane; v4f v[8]; float s = 0.f;
#pragma unroll
    for (int j = 0; j < 8; ++j) { v[j] = xr[64 * j]; s += (v[j].x * v[j].x + v[j].y * v[j].y) + (v[j].z * v[j].z + v[j].w * v[j].w); }
    const float r = rsqrtf(wave_sum(s, lane) * (1.f / DM) + EPS);
    const v4f* gr = (const v4f*)g + lane; v2u* o8 = (v2u*)orow + lane;
#pragma unroll
    for (int j = 0; j < 8; ++j) { const v4f gg = gr[64 * j]; v2u o; o.x = pk2(v[j].x * r * gg.x, v[j].y * r * gg.y); o.y = pk2(v[j].z * r * gg.z, v[j].w * r * gg.w); o8[64 * j] = o; }
}
__device__ __forceinline__ void resid_norm_row(const float* yrow, const float* xi, float* xo, const float* g1, const float* g2, bf16* hn, int lane) {
    const v4f* yr = (const v4f*)yrow + lane; const v4f* xr = (const v4f*)xi + lane; v4f v[8]; float s = 0.f;
#pragma unroll
    for (int j = 0; j < 8; ++j) { v[j] = yr[64 * j]; s += (v[j].x * v[j].x + v[j].y * v[j].y) + (v[j].z * v[j].z + v[j].w * v[j].w); }
    const float r = rsqrtf(wave_sum(s, lane) * (1.f / DM) + EPS);
    const v4f* gr = (const v4f*)g1 + lane; v4f* xw = (v4f*)xo + lane; float s2 = 0.f;
#pragma unroll
    for (int j = 0; j < 8; ++j) { const v4f gg = gr[64 * j]; const v4f xx = xr[64 * j]; v[j] = xx + v[j] * r * gg; xw[64 * j] = v[j]; s2 += (v[j].x * v[j].x + v[j].y * v[j].y) + (v[j].z * v[j].z + v[j].w * v[j].w); }
    if (hn) { const float r2 = rsqrtf(wave_sum(s2, lane) * (1.f / DM) + EPS); const v4f* g2r = (const v4f*)g2 + lane; v2u* o8 = (v2u*)hn + lane;
#pragma unroll
        for (int j = 0; j < 8; ++j) { const v4f gg = g2r[64 * j]; v2u o; o.x = pk2(v[j].x * r2 * gg.x, v[j].y * r2 * gg.y); o.y = pk2(v[j].z * r2 * gg.z, v[j].w * r2 * gg.w); o8[64 * j] = o; } }
}

__device__ __forceinline__ void ssm_params(KP p, int l, int g, int n, float& lr, float& li, float (&bbr)[16], float (&bbi)[16]) {
    const float ar = p->in[3][(l * 32 + g) * 64 + n], ai = p->in[4][(l * 32 + g) * 64 + n];
    const float dt = expf(p->in[5][l * 32 + g]);
    const float mag = expf(ar * dt), ang = ai * dt;
    lr = mag * cosf(ang); li = mag * sinf(ang);
    const float den = ar * ar + ai * ai;
    const float fr = ((lr - 1.0f) * ar + li * ai) / den, fi = (li * ar - (lr - 1.0f) * ai) / den;
    const v4f* br = (const v4f*)(p->in[6] + ((size_t)(l * 32 + g) * 64 + n) * 16); const v4f* bi = (const v4f*)(p->in[7] + ((size_t)(l * 32 + g) * 64 + n) * 16);
#pragma unroll
    for (int q = 0; q < 4; ++q) { const v4f a = br[q], b = bi[q];
#pragma unroll
        for (int j = 0; j < 4; ++j) { bbr[4 * q + j] = fr * a[j] - fi * b[j]; bbi[4 * q + j] = fr * b[j] + fi * a[j]; } }
}
#define SSM_BU(t, br_, bi_) do { br_ = 0.f; bi_ = 0.f; _Pragma("unroll") for (int j = 0; j < 8; ++j) { const unsigned w_ = (unsigned)__builtin_amdgcn_readlane((int)ur[j], (t)); const float ua_ = bflo(w_), ub_ = bfhi(w_); \
        br_ = fmaf(bbr[2 * j], ua_, br_); br_ = fmaf(bbr[2 * j + 1], ub_, br_); bi_ = fmaf(bbi[2 * j], ua_, bi_); bi_ = fmaf(bbi[2 * j + 1], ub_, bi_); } } while (0)

__device__ __forceinline__ void ssm_pass1_job(KP p, int l, int job, int wave, int lane, const bf16* P, float* Send) {
    const int co = job & 3, g = (job >> 2) & 31, b = job >> 7, chunk = co * 8 + wave;
    float lr, li, bbr[16], bbi[16]; ssm_params(p, l, g, lane, lr, li, bbr, bbi);
    const size_t row0 = (size_t)b * SEQ + chunk * 64;
    const v4u* up = (const v4u*)(P + (row0 + lane) * PCOLS + g * 16);
    const v4u u0 = up[0], u1 = up[1]; const unsigned ur[8] = {u0.x, u0.y, u0.z, u0.w, u1.x, u1.y, u1.z, u1.w};
    float sr = 0.f, si = 0.f;
#pragma unroll 1
    for (int t = 0; t < 64; ++t) { float br_, bi_; SSM_BU(t, br_, bi_); const float nr = lr * sr - li * si + br_, ni = lr * si + li * sr + bi_; sr = nr; si = ni; }
    *(v2f*)(Send + ((size_t)((b * 32 + g) * 32 + chunk) * 64 + lane) * 2) = (v2f){sr, si};
}
__device__ __forceinline__ void ssm_pass2_job(KP p, int l, int job, int tid, int wave, int lane, const bf16* P, const float* Send, bf16* Z, LAS unsigned char* lds) {
    const int co = job & 3, g = (job >> 2) & 31, b = job >> 7, chunk = co * 8 + wave;
    LAS float* Cr = (LAS float*)lds; LAS float* Ci = (LAS float*)(lds + 4224);
    LAS float* Sr = (LAS float*)(lds + 8448 + wave * 8448); LAS float* Si = Sr + 16 * 65;
    for (int i = tid; i < 1024; i += NTHREADS) { const int pp = i >> 6, n = i & 63; Cr[pp * 65 + n] = p->in[8][(size_t)(l * 32 + g) * 1024 + i]; Ci[pp * 65 + n] = p->in[9][(size_t)(l * 32 + g) * 1024 + i]; }
    __syncthreads();
    float lr, li, bbr[16], bbi[16]; ssm_params(p, l, g, lane, lr, li, bbr, bbi);
    float pr = lr, pi = li;
#pragma unroll
    for (int q = 0; q < 6; ++q) { const float nr = pr * pr - pi * pi, ni = 2.f * pr * pi; pr = nr; pi = ni; }
    float sr = 0.f, si = 0.f;
    { const v2f* se = (const v2f*)Send + (size_t)((b * 32 + g) * 32) * 64 + lane;
      for (int c = 0; c < chunk; ++c) { const v2f e = se[(size_t)c * 64]; const float nr = pr * sr - pi * si + e.x, ni = pr * si + pi * sr + e.y; sr = nr; si = ni; } }
    const size_t row0 = (size_t)b * SEQ + chunk * 64;
    const v4u* up = (const v4u*)(P + (row0 + lane) * PCOLS + g * 16);
    const v4u u0 = up[0], u1 = up[1]; const unsigned ur[8] = {u0.x, u0.y, u0.z, u0.w, u1.x, u1.y, u1.z, u1.w};
    const int pp = lane & 15, tq = lane >> 4; const float dsk = p->in[10][l * 512 + g * 16 + pp];
#pragma unroll 1
    for (int sub = 0; sub < 4; ++sub) {
#pragma unroll 1
        for (int tt = 0; tt < 16; ++tt) { float br_, bi_; SSM_BU(sub * 16 + tt, br_, bi_); const float nr = lr * sr - li * si + br_, ni = lr * si + li * sr + bi_; sr = nr; si = ni; Sr[tt * 65 + lane] = sr; Si[tt * 65 + lane] = si; }
        LDS_WAIT(); __builtin_amdgcn_wave_barrier();
        float y[4] = {0.f, 0.f, 0.f, 0.f};
#pragma unroll 4
        for (int n = 0; n < 64; ++n) { const float cr = Cr[pp * 65 + n], ci = Ci[pp * 65 + n];
#pragma unroll
            for (int i = 0; i < 4; ++i) { y[i] = fmaf(cr, Sr[(tq * 4 + i) * 65 + n], y[i]); y[i] = fmaf(-ci, Si[(tq * 4 + i) * 65 + n], y[i]); } }
#pragma unroll
        for (int i = 0; i < 4; ++i) { const size_t row = row0 + sub * 16 + tq * 4 + i; const float uv = bf1(P + row * PCOLS + g * 16 + pp);
            Z[row * 512 + g * 16 + pp] = (bf16)f2bf(gelu_tanh(y[i] + dsk * uv)); }
        LDS_WAIT(); __builtin_amdgcn_wave_barrier();
    }
    __syncthreads();
}

__device__ __forceinline__ void pool_job(int job, int tid, const bf16* P, bf16* pooled) {
    const int b = job >> 6, t0 = (job & 63) * 32, c = tid, w = 2 << (c >> 7);
    const bf16* U = P + (size_t)b * SEQ * PCOLS + 512 + c;
    float sum = 0.f;
    for (int tt = t0 - w + 1; tt < t0; ++tt) if (tt >= 0) sum += bf1(U + (size_t)tt * PCOLS);
    for (int t = t0; t < t0 + 32; ++t) {
        const float ut = bf1(U + (size_t)t * PCOLS); sum += ut;
        const int cnt = (t + 1 < w) ? (t + 1) : w;
        pooled[((size_t)b * SEQ + t) * 512 + c] = (bf16)f2bf(sum / (float)cnt - ut);
        const int tl = t - w + 1; if (tl >= 0) sum -= bf1(U + (size_t)tl * PCOLS);
    }
}

__device__ __forceinline__ void conv_job(KP p, int l, int job, int tid, int wave, int lane, const bf16* P, bf16* ys, LAS unsigned char* lds) {
    const int b = job >> 7, t0 = (job & 127) * 16, c = tid;
    LAS float* Y = (LAS float*)lds;
    float v[46];
    const bf16* base = P + (size_t)b * SEQ * PCOLS + 1024 + c;
#pragma unroll
    for (int j = 0; j < 46; ++j) { const int tt = t0 - 30 + j; float x = 0.f; if (tt >= 0) { const float val = bf1(base + (size_t)tt * PCOLS), gate = bf1(base + (size_t)tt * PCOLS + 512); x = val * sigmoid_f(gate); } v[j] = x; }
    float y[16]; const float cb = p->in[15][l * 512 + c];
#pragma unroll
    for (int t = 0; t < 16; ++t) y[t] = cb;
#pragma unroll
    for (int k = 0; k < 31; ++k) { const float wk = p->in[14][(size_t)(l * 31 + k) * 512 + c];
#pragma unroll
        for (int t = 0; t < 16; ++t) y[t] = fmaf(wk, v[t + k], y[t]); }
#pragma unroll
    for (int t = 0; t < 16; ++t) Y[t * 512 + c] = y[t];
    __syncthreads();
#pragma unroll
    for (int q = 0; q < 2; ++q) { const int t = wave * 2 + q;
        const v4f a = *(const LAS v4f*)(Y + t * 512 + 8 * lane), bq = *(const LAS v4f*)(Y + t * 512 + 8 * lane + 4);
        float x[8] = {a.x, a.y, a.z, a.w, bq.x, bq.y, bq.z, bq.w};
        float s = 0.f;
#pragma unroll
        for (int i = 0; i < 8; ++i) s += x[i];
        const float mu = wave_sum(s, lane) * (1.f / 512.f); float s2 = 0.f;
#pragma unroll
        for (int i = 0; i < 8; ++i) { x[i] -= mu; s2 += x[i] * x[i]; }
        const float rstd = rsqrtf(wave_sum(s2, lane) * (1.f / 512.f) + EPS);
        const float* lg = p->in[16] + l * 512 + 8 * lane; const float* lb = p->in[17] + l * 512 + 8 * lane;
        float o[8];
#pragma unroll
        for (int i = 0; i < 8; ++i) { const float z = x[i] * rstd * lg[i] + lb[i]; o[i] = z * sigmoid_f(z); }
        v4u w; w.x = pk2(o[0], o[1]); w.y = pk2(o[2], o[3]); w.z = pk2(o[4], o[5]); w.w = pk2(o[6], o[7]);
        *(v4u*)(ys + ((size_t)b * SEQ + t0 + t) * DM + 1024 + 8 * lane) = w; }
    __syncthreads();
}

__device__ __forceinline__ void gmlp_job(KP p, int l, int job, int tid, int wave, int lane, const bf16* P, bf16* ys, LAS unsigned char* lds) {
    const int h = job & 3; const size_t row0 = (size_t)(job >> 2) * 128;
    LAS float* vn = (LAS float*)lds;
    for (int tt = 0; tt < 16; ++tt) { const int s = wave * 16 + tt;
        const v4u raw = *(const v4u*)(P + (row0 + s) * PCOLS + 2560 + 8 * lane);
        float x[8] = {bflo(raw.x), bfhi(raw.x), bflo(raw.y), bfhi(raw.y), bflo(raw.z), bfhi(raw.z), bflo(raw.w), bfhi(raw.w)};
        float sm = 0.f;
#pragma unroll
        for (int i = 0; i < 8; ++i) { x[i] = gelu_tanh(x[i]); sm += x[i]; }
        const float mu = wave_sum(sm, lane) * (1.f / 512.f); float s2 = 0.f;
#pragma unroll
        for (int i = 0; i < 8; ++i) { x[i] -= mu; s2 += x[i] * x[i]; }
        const float rstd = rsqrtf(wave_sum(s2, lane) * (1.f / 512.f) + EPS);
        if ((lane >> 4) == h) { const float* lg = p->in[18] + l * 512 + 8 * lane; const float* lb = p->in[19] + l * 512 + 8 * lane;
            v4f o0, o1;
#pragma unroll
            for (int i = 0; i < 4; ++i) { o0[i] = x[i] * rstd * lg[i] + lb[i]; o1[i] = x[4 + i] * rstd * lg[4 + i] + lb[4 + i]; }
            *(LAS v4f*)(vn + s * 128 + 8 * (lane & 15)) = o0; *(LAS v4f*)(vn + s * 128 + 8 * (lane & 15) + 4) = o1; } }
    __syncthreads();
    const int d = tid & 127, tg = __builtin_amdgcn_readfirstlane(tid >> 7);
    const float* Wsh = p->in[20] + (size_t)(l * 4 + h) * 128 * 128; const float* bs = p->in[21] + (l * 4 + h) * 128;
#pragma unroll 1
    for (int jj = 0; jj < 8; ++jj) {
        float acc[4] = {0.f, 0.f, 0.f, 0.f};
        const int tb = jj * 16 + tg, smax = tb + 12;
        for (int s4 = 0; s4 <= (smax >> 2); ++s4) { const int s = 4 * s4;
            const float v0 = vn[(s + 0) * 128 + d], v1 = vn[(s + 1) * 128 + d], v2 = vn[(s + 2) * 128 + d], v3 = vn[(s + 3) * 128 + d];
#pragma unroll
            for (int i = 0; i < 4; ++i) { const int t = tb + 4 * i; const v4f w = *(const v4f*)(Wsh + t * 128 + s);
                const float w0 = (s + 0 <= t) ? w.x : 0.f, w1 = (s + 1 <= t) ? w.y : 0.f, w2 = (s + 2 <= t) ? w.z : 0.f, w3 = (s + 3 <= t) ? w.w : 0.f;
                acc[i] += (w0 * v0 + w1 * v1) + (w2 * v2 + w3 * v3); } }
#pragma unroll
        for (int i = 0; i < 4; ++i) { const int t = tb + 4 * i; const float uu = gelu_tanh(bf1(P + (row0 + t) * PCOLS + 2048 + h * 128 + d));
            ys[(row0 + t) * DM + 1536 + h * 128 + d] = (bf16)f2bf(uu * (acc[i] + bs[t])); } }
    __syncthreads();
}


#define XB_TMO      128
#define XB_XCNT(j)  (256  + 64 * (j))
#define XB_XSUB(j)  (1280 + 64 * (j))
#define XB_XGEN(j)  (2304 + 64 * (j))
#define XB_TOP      3328
#define XB_TOPGEN   3392
#define XCD_BAR_WORDS 3456
#define XB_SPIN_CAP (1u << 18)
__device__ __forceinline__ unsigned xb_ld(unsigned* p)              { return __hip_atomic_load(p, __ATOMIC_RELAXED, __HIP_MEMORY_SCOPE_AGENT); }
__device__ __forceinline__ unsigned xb_add(unsigned* p, unsigned v) { return __hip_atomic_fetch_add(p, v, __ATOMIC_RELAXED, __HIP_MEMORY_SCOPE_AGENT); }
__device__ __forceinline__ unsigned xb_xcc_id() { return (unsigned)__builtin_amdgcn_s_getreg((3 << 11) | 20) & 0xFu; }
#define XB_SPIN(cond, bar) do { unsigned _sp = 0; while (cond) { __builtin_amdgcn_s_sleep(1); \
    if ((++_sp & 255u) == 0u) { if (xb_ld(&(bar)[XB_TMO])) break; if (_sp > XB_SPIN_CAP) { atomicAdd(&(bar)[XB_TMO], 1u); break; } } } } while (0)
__device__ __forceinline__ void xcd_barrier_complete(unsigned* bar, unsigned x, unsigned G, unsigned& nloc, unsigned& nx) {
    unsigned sum, cnt, mine, sp = 0u;
    for (;;) {
        sum = 0u; cnt = 0u; mine = 0u;
#pragma unroll
        for (unsigned j = 0; j < 16; ++j) { const unsigned c = xb_ld(&bar[XB_XCNT(j)]); sum += c; cnt += (c > 0u) ? 1u : 0u; mine = (j == x) ? c : mine; }
        if (sum == G) break;
        __builtin_amdgcn_s_sleep(1);
        if ((++sp & 255u) == 0u) { if (xb_ld(&bar[XB_TMO])) break; if (sp > XB_SPIN_CAP) { atomicAdd(&bar[XB_TMO], 1u); break; } }
    }
    nloc = mine > 0u ? mine : 1u; nx = cnt > 0u ? cnt : 1u;
}
__device__ __forceinline__ void xcd_barrier(unsigned* bar, volatile LAS unsigned* st, bool first, unsigned G) {
    asm volatile("s_waitcnt vmcnt(0)" ::: "memory");
    __syncthreads();
    if (first) {
        const unsigned x = xb_xcc_id();
        __builtin_amdgcn_s_waitcnt(0);
        unsigned nloc = st[0], nx = st[1];
        if (nloc == 0u) { xcd_barrier_complete(bar, x, G, nloc, nx); st[0] = nloc; st[1] = nx; }
        const unsigned old = xb_add(&bar[XB_XSUB(x)], 1u);
        const unsigned gen = old / nloc;
        if (old + 1u == (gen + 1u) * nloc) {
            __builtin_amdgcn_fence(__ATOMIC_RELEASE, "agent");
            asm volatile("s_waitcnt vmcnt(0)" ::: "memory");
            const unsigned og = xb_add(&bar[XB_TOP], 1u);
            const unsigned tg = og / nx;
            if (og + 1u == (tg + 1u) * nx) xb_add(&bar[XB_TOPGEN], 1u);
            else XB_SPIN(xb_ld(&bar[XB_TOPGEN]) == tg, bar);
            __builtin_amdgcn_fence(__ATOMIC_ACQUIRE, "agent");
            xb_add(&bar[XB_XGEN(x)], 1u);
            asm volatile("s_waitcnt vmcnt(0)" ::: "memory");
        } else {
            XB_SPIN(xb_ld(&bar[XB_XGEN(x)]) == gen, bar);
            __builtin_amdgcn_fence(__ATOMIC_ACQUIRE, "agent");
            asm volatile("s_waitcnt vmcnt(0)" ::: "memory");
        }
    }
    __syncthreads();
}

#ifndef PHMASK
#define PHMASK 0xFFFFFFFFu
#endif
#ifndef PHREP
#define PHREP 0u
#endif
#define NREP(k) (1 + (int)((PHREP >> (k)) & 1u))
#define PH_BEGIN() KP p = kargs(); int wave = wave_s; asm volatile("" : "+s"(wave)); int lane; asm volatile("v_mbcnt_lo_u32_b32 %0, -1, 0\n\tv_mbcnt_hi_u32_b32 %0, -1, %0" : "=v"(lane)); const int tid = wave * 64 + lane; \
    int bid = blockIdx.x, G = gridDim.x; asm volatile("" : "+s"(bid), "+s"(G)); const int gw = bid * NWAVES + wave, NGW = G * NWAVES; unsigned char* ws = p->ws; (void)lane; (void)gw; (void)NGW; (void)ws
#define GRID_BAR() do { KP q_ = kargs(); int w_ = wave_s; asm volatile("" : "+s"(w_)); int l_; asm volatile("v_mbcnt_lo_u32_b32 %0, -1, 0\n\tv_mbcnt_hi_u32_b32 %0, -1, %0" : "=v"(l_)); \
    xcd_barrier((unsigned*)(q_->ws + WS_BAR), (volatile LAS unsigned*)(lds + LDS_ST_OFF), (w_ == 0 && l_ == 0), (unsigned)gridDim.x); } while (0)
__global__ void __launch_bounds__(NTHREADS, 2) hybrid_fwd(Params p_unused) {
    extern __shared__ __attribute__((aligned(16))) unsigned char lds_raw[];
    LAS unsigned char* lds = (LAS unsigned char*)lds_raw;
    cg::grid_group grid = cg::this_grid();
    const int wave_s = __builtin_amdgcn_readfirstlane((int)threadIdx.x >> 6);

    { PH_BEGIN(); if (tid < 2) ((LAS unsigned*)(lds + LDS_ST_OFF))[tid] = 0u;
      if (bid == 0) for (int i = tid; i < XCD_BAR_WORDS; i += NTHREADS) ((unsigned*)(ws + WS_BAR))[i] = 0u; }
    if (PHMASK & (1u << 0)) { PH_BEGIN();
        LAS float* scr = (LAS float*)(lds + wave * 16384);
        constexpr int I_IN = (DM / 64) * (INC / 32), I_FF1 = (DM / 64) * (DFF / 32), I_FF2 = (DFF / 64) * (DM / 32), I_SQ = (DM / 64) * (DM / 32), I_GLU = (512 / 64) * (1024 / 32);
        constexpr int PER_L = I_IN + I_FF1 + I_FF2 + 2 * I_SQ + I_GLU;
        for (int it0 = gw; it0 < DEPTH * PER_L * NREP(0); it0 += NGW) { const int it = it0 % (DEPTH * PER_L);
            const int l = it / PER_L; int r = it % PER_L;
            if (r < I_IN) { transpose_item(p->in[2] + (size_t)l * DM * INC, DM, INC, (bf16*)(ws + WS_WIN + l * L_WIN), scr, r, lane, 0); continue; } r -= I_IN;
            if (r < I_FF1) { transpose_item(p->in[26] + (size_t)l * DM * DFF, DM, DFF, (bf16*)(ws + WS_WFF1 + l * L_WFF), scr, r, lane, 0); continue; } r -= I_FF1;
            if (r < I_FF2) { transpose_item(p->in[27] + (size_t)l * DFF * DM, DFF, DM, (bf16*)(ws + WS_WFF2 + l * L_WFF), scr, r, lane, 0); continue; } r -= I_FF2;
            if (r < I_SQ) { transpose_item(p->in[23] + (size_t)l * DM * DM, DM, DM, (bf16*)(ws + WS_WO + l * L_WSQ), scr, r, lane, 0); continue; } r -= I_SQ;
            if (r < I_SQ) { transpose_item(p->in[22] + (size_t)l * DM * DM, DM, DM, (bf16*)(ws + WS_WBR + l * L_WSQ), scr, r, lane, 0); continue; } r -= I_SQ;
            transpose_item(p->in[11] + (size_t)l * 512 * 1024, 512, 1024, (bf16*)(ws + WS_WGLU + l * L_WGLU), scr, r, lane, 1);
        }
        for (int i = bid * NTHREADS + tid; i < DEPTH * 512 * 256; i += G * NTHREADS) { const int l = i / (512 * 256), r = i % (512 * 256), n = r >> 8, kk = r & 255, g = n >> 7, d = n & 127, cc = kk - 128 * (g & 1);
            const float v = (cc >= 0 && cc < 128) ? p->in[12][((size_t)(l * 4 + g) * 128 + cc) * 128 + d] : 0.f;
            ((bf16*)(ws + WS_WPOOL + l * L_WPOOL))[r] = (bf16)f2bf(v); }
        for (int m = gw; m < MTOK; m += NGW) rms_row_to_bf16(p->in[0] + (size_t)m * DM, p->in[1], (bf16*)(ws + WS_H) + (size_t)m * DM, lane);
    }
    grid.sync();
    { PH_BEGIN(); if (tid == 0) (void)xb_add(&((unsigned*)(ws + WS_BAR))[XB_XCNT(xb_xcc_id())], 1u); }

#pragma unroll 1
    for (int l = 0; l < DEPTH; ++l) {
        if (PHMASK & (1u << 1)) { PH_BEGIN();
          pg8::Gemm g{(const bf16*)(ws + WS_H), (const bf16*)(ws + WS_WIN + l * L_WIN), MTOK, INC, DM, DM, DM, 0}; pg8::StaticOrder S; S.init(MTOK, INC, G, bid); S.reps = NREP(1);
          pg8::EpiBf16<0> E{(bf16*)(ws + WS_P), PCOLS, (bf16*)(ws + WS_G), 8192, nullptr, 0};
          pg8::gemm_phase<pg8::EpiBf16<0>, pg8::StaticOrder, true, true>(lds, g, S, E, wave, lane); }
        GRID_BAR();
        if (PHMASK & (1u << 2)) { PH_BEGIN();
          const bf16* Pb = (const bf16*)(ws + WS_P); bf16* YS = (bf16*)(ws + WS_YS);
          for (int j0 = bid; j0 < (256 + 512 + 512 + 256) * NREP(2); j0 += G) { const int j = j0 % (256 + 512 + 512 + 256);
            if (j < 256) gmlp_job(p, l, j, tid, wave, lane, Pb, YS, lds);
            else if (j < 768) ssm_pass1_job(p, l, j - 256, wave, lane, Pb, (float*)(ws + WS_SEND));
            else if (j < 1280) conv_job(p, l, j - 768, tid, wave, lane, Pb, YS, lds);
            else pool_job(j - 1280, tid, Pb, (bf16*)(ws + WS_POOLED));
          } }
        GRID_BAR();
        if (PHMASK & (1u << 3)) { PH_BEGIN();
          for (int j0 = bid; j0 < 512 * NREP(3); j0 += G) ssm_pass2_job(p, l, j0 % 512, tid, wave, lane, (const bf16*)(ws + WS_P), (const float*)(ws + WS_SEND), (bf16*)(ws + WS_Z), lds); }
        GRID_BAR();
        if (PHMASK & (1u << 4)) { PH_BEGIN();
          const bool split = (G >= 192);
          pg8::Gemm g{(const bf16*)(ws + WS_Z), (const bf16*)(ws + WS_WGLU + l * L_WGLU), MTOK, 1024, 512, 512, 512, 0}; pg8::StaticOrder S; S.init(MTOK, 1024, split ? 128 : G, split ? (bid < 128 ? bid : -1) : bid); S.reps = NREP(4);
          pg8::EpiGlu E{(bf16*)(ws + WS_YS), DM};
          pg8::gemm_phase<pg8::EpiGlu, pg8::StaticOrder, true, true>(lds, g, S, E, wave, lane); }
        if (PHMASK & (1u << 4)) { PH_BEGIN();
          const bool split = (G >= 192);
          pg8::Gemm g{(const bf16*)(ws + WS_POOLED), (const bf16*)(ws + WS_WPOOL + l * L_WPOOL), MTOK, 512, 256, 512, 256, 256}; pg8::StaticOrder S; S.init(MTOK, 512, split ? 64 : G, split ? ((bid >= 128 && bid < 192) ? bid - 128 : -1) : bid); S.reps = NREP(4);
          pg8::EpiBf16<2> E{(bf16*)(ws + WS_YS), DM, nullptr, 0, p->in[13] + l * 512, 512};
          pg8::gemm_phase<pg8::EpiBf16<2>, pg8::StaticOrder, true, true>(lds, g, S, E, wave, lane); }
        GRID_BAR();
        if (PHMASK & (1u << 5)) { PH_BEGIN();
          pg8::Gemm g{(const bf16*)(ws + WS_YS), (const bf16*)(ws + WS_WBR + l * L_WSQ), MTOK, DM, 512, DM, DM, 0}; pg8::SegOrder S; S.init(MTOK, DM, G, bid); S.reps = NREP(5);
          pg8::EpiBranch E{(bf16*)(ws + WS_MERGED), DM, (const bf16*)(ws + WS_G)};
          pg8::gemm_phase<pg8::EpiBranch, pg8::SegOrder, true, true>(lds, g, S, E, wave, lane); }
        GRID_BAR();
        if (PHMASK & (1u << 6)) { PH_BEGIN();
          pg8::Gemm g{(const bf16*)(ws + WS_MERGED), (const bf16*)(ws + WS_WO + l * L_WSQ), MTOK, DM, DM, DM, DM, 0}; pg8::StaticOrder S; S.init(MTOK, DM, G, bid); S.reps = NREP(6);
          pg8::EpiF32 E{(float*)(ws + WS_MIX), DM};
          pg8::gemm_phase<pg8::EpiF32, pg8::StaticOrder, true, true>(lds, g, S, E, wave, lane); }
        GRID_BAR();
        if (PHMASK & (1u << 7)) { PH_BEGIN();
          const float* xin = (l == 0) ? p->in[0] : p->out; float* xo = p->out; const float* MIX = (const float*)(ws + WS_MIX); bf16* Hb = (bf16*)(ws + WS_H);
          for (int m = gw; m < MTOK; m += NGW) resid_norm_row(MIX + (size_t)m * DM, xin + (size_t)m * DM, xo + (size_t)m * DM, p->in[24] + l * DM, p->in[25] + l * DM, Hb + (size_t)m * DM, lane); }
        GRID_BAR();
        if (PHMASK & (1u << 8)) { PH_BEGIN();
          pg8::Gemm g{(const bf16*)(ws + WS_H), (const bf16*)(ws + WS_WFF1 + l * L_WFF), MTOK, DFF, DM, DM, DM, 0}; pg8::StaticOrder S; S.init(MTOK, DFF, G, bid); S.reps = NREP(8);
          pg8::EpiBf16<1> E{(bf16*)(ws + WS_G), DFF, nullptr, 0, nullptr, 0};
          pg8::gemm_phase<pg8::EpiBf16<1>, pg8::StaticOrder, true, true>(lds, g, S, E, wave, lane); }
        GRID_BAR();
        if (PHMASK & (1u << 9)) { PH_BEGIN();
          pg8::Gemm g{(const bf16*)(ws + WS_G), (const bf16*)(ws + WS_WFF2 + l * L_WFF), MTOK, DM, DFF, DFF, DFF, 0}; pg8::StaticOrder S; S.init(MTOK, DM, G, bid); S.reps = NREP(9);
          pg8::EpiF32 E{(float*)(ws + WS_MIX), DM};
          pg8::gemm_phase<pg8::EpiF32, pg8::StaticOrder, true, true>(lds, g, S, E, wave, lane); }
        GRID_BAR();
        if (PHMASK & (1u << 10)) { PH_BEGIN();
          const bool more = (l + 1 < DEPTH); float* xo = p->out; const float* MIX = (const float*)(ws + WS_MIX); bf16* Hb = (bf16*)(ws + WS_H);
          for (int m = gw; m < MTOK; m += NGW) resid_norm_row(MIX + (size_t)m * DM, xo + (size_t)m * DM, xo + (size_t)m * DM, p->in[28] + l * DM, more ? p->in[1] + (l + 1) * DM : nullptr, more ? Hb + (size_t)m * DM : nullptr, lane); }
        if (l + 1 < DEPTH) GRID_BAR();
    }
}

extern "C" void kernel_launch(void* const* d_in, const int* in_sizes, int n_in, void* d_out, int out_size, void* d_ws, size_t ws_size, hipStream_t stream) {
    static int grid = 0;
    if (grid == 0) {
        if (n_in != 29 || out_size != MTOK * DM || ws_size < WS_END) { fprintf(stderr, "kernel_launch: unexpected shapes (n_in %d, out %d, ws %zu < %zu)\n", n_in, out_size, ws_size, (size_t)WS_END); grid = -1; return; }
        int dev = 0, cus = 0, per_cu = 0;
        if (hipGetDevice(&dev) != hipSuccess || hipDeviceGetAttribute(&cus, hipDeviceAttributeMultiprocessorCount, dev) != hipSuccess) { grid = -1; return; }
        if (hipFuncSetAttribute((const void*)hybrid_fwd, hipFuncAttributeMaxDynamicSharedMemorySize, LDS_BYTES) != hipSuccess) { fprintf(stderr, "kernel_launch: hipFuncSetAttribute failed\n"); grid = -1; return; }
        if (hipOccupancyMaxActiveBlocksPerMultiprocessor(&per_cu, (const void*)hybrid_fwd, NTHREADS, LDS_BYTES) != hipSuccess || per_cu < 1) { fprintf(stderr, "kernel_launch: occupancy query says %d blocks/CU\n", per_cu); (void)hipGetLastError(); grid = -1; return; }
        grid = cus * per_cu; if (grid > 256) grid = 256;
    }
    if (grid < 0) return;
    Params p{};
    for (int i = 0; i < 29; ++i) p.in[i] = (const float*)d_in[i];
    p.out = (float*)d_out; p.ws = (unsigned char*)d_ws;
    void* args[] = {&p};
    hipError_t e = hipLaunchCooperativeKernel((const void*)hybrid_fwd, dim3(grid), dim3(NTHREADS), args, LDS_BYTES, stream);
    if (e != hipSuccess) fprintf(stderr, "cooperative launch failed: %s (grid %d)\n", hipGetErrorString(e), grid);
}
```

```cpp
#include <hip/hip_runtime.h>
#include <hip/hip_cooperative_groups.h>
#include <cstdio>
#include <cstdint>
namespace cg = cooperative_groups;

namespace pg8 {
#define PG8_LAS __attribute__((address_space(3)))
typedef unsigned short bf16_t;
typedef short bf16x8 __attribute__((ext_vector_type(8)));
typedef float f32x4 __attribute__((ext_vector_type(4)));
typedef unsigned u32x4 __attribute__((ext_vector_type(4)));
typedef unsigned u32x2 __attribute__((ext_vector_type(2)));
constexpr int BM = 256, BK = 64, HALF = 128, HTB = HALF * BK * 2  , STAGE_BYTES = 8 * HTB, NXCD = 8, WGM = 8;

__host__ __device__ __forceinline__ int lds_byte(int r, int c) { const int st = (r >> 4) * 2 + (c >> 5), rr = r & 15, cc = c & 31, ob = rr * 64 + cc * 2; return st * 1024 + (ob ^ (((ob >> 9) & 1) << 5)); }
__host__ __device__ __forceinline__ void stage_rc(int b, int& R, int& C) { const int st = b / 1024, sb = b % 1024, swz = sb ^ (((sb >> 9) & 1) << 5); R = (st >> 1) * 16 + swz / 64; C = (st & 1) * 32 + (swz % 64) / 2; }
__host__ __device__ __forceinline__ int perm32(int rho) { const int n = rho >> 4, i = rho & 15; return 8 * (i >> 2) + 4 * n + (i & 3); }

struct Unit { int pm, pn, seg; };
struct Gemm { const bf16_t* A; const bf16_t* Bt; int M, N, K, lda, ldb, a_pn_off; };

struct StaticOrder {
    int nM, nN, nwg, G, c, reps;
    __host__ __device__ void init(int M, int N, int G_, int c_) { nM = M / BM; nN = N / BM; nwg = nM * nN; G = G_; c = c_; reps = 1; }
    __host__ __device__ bool next(int i, Unit& u) const {
        if (c < 0 || c >= nwg) return false; { const int nc = (nwg - c + G - 1) / G; if (i >= reps * nc) return false; i = i % nc; }
        const long L = (long)i * G + c;
        int wgid = (int)L; { const int q = nwg / NXCD, r = nwg % NXCD, xcd = wgid % NXCD, off = wgid / NXCD; wgid = (xcd < r ? xcd * (q + 1) : r * (q + 1) + (xcd - r) * q) + off; }
        const int nig = WGM * nN, gid = wgid / nig, fm = gid * WGM, gsz = (nM - fm) < WGM ? (nM - fm) : WGM;
        u.pm = fm + ((wgid % nig) % gsz); u.pn = (wgid % nig) / gsz; u.seg = 0; return true;
    }
    __device__ __forceinline__ void a_ready(const Unit&) const {}
    __device__ __forceinline__ void done(const Unit&) const {}
};
struct SegOrder : StaticOrder {
    __host__ __device__ bool next(int i, Unit& u) const { if (!StaticOrder::next(i >> 2, u)) return false; u.seg = i & 3; return true; }
};

__device__ __forceinline__ unsigned cvt_pk_bf16(float lo, float hi) { unsigned r; asm volatile("v_cvt_pk_bf16_f32 %0, %1, %2" : "=v"(r) : "v"(lo), "v"(hi)); return r; }
__device__ __forceinline__ float bf_lo(unsigned w) { return __uint_as_float(w << 16); }
__device__ __forceinline__ float bf_hi(unsigned w) { return __uint_as_float(w & 0xffff0000u); }
__device__ __forceinline__ float sigm(float x) { return __builtin_amdgcn_rcpf(1.0f + __expf(-x)); }

struct EpiF32 {
    static constexpr bool PERM = false, AFTER_DRAIN = false, KHOOK = false;
    float* C; int ldc;
    __device__ __forceinline__ void operator()(f32x4 (&acc)[2][2][4][2], const Unit& u, int wr, int wc, int fr, int fq) const {
        const int row0 = u.pm * BM + wr * 64 + fr, col0 = u.pn * BM + wc * 32 + 4 * fq;
#pragma unroll
        for (int ai = 0; ai < 2; ++ai)
#pragma unroll
            for (int m = 0; m < 4; ++m) { float* rowp = C + (size_t)(row0 + ai * HALF + m * 16) * ldc + col0;
#pragma unroll
                for (int bj = 0; bj < 2; ++bj)
#pragma unroll
                    for (int n = 0; n < 2; ++n) *(f32x4*)(rowp + bj * HALF + n * 16) = acc[ai][bj][m][n]; }
    }
};
template <int ACT> struct EpiBf16 {
    static constexpr bool PERM = true, AFTER_DRAIN = false, KHOOK = false;
    bf16_t* O; int ldc; bf16_t* O2; int ldc2; const float* scale; int coff;
    __device__ __forceinline__ void operator()(f32x4 (&acc)[2][2][4][2], const Unit& u, int wr, int wc, int fr, int fq) const {
        const int row0 = u.pm * BM + wr * 64 + fr; int colt = u.pn * BM; bf16_t* base = O; int ld = ldc; bool sg = false;
        if (ACT == 0 && u.pn >= 12) { base = O2; ld = ldc2; colt -= 12 * BM; sg = true; }
        const int col0 = colt + wc * 32 + 8 * fq + (ACT == 2 ? coff : 0), scol0 = u.pn * BM + wc * 32 + 8 * fq;
#pragma unroll
        for (int ai = 0; ai < 2; ++ai)
#pragma unroll
            for (int m = 0; m < 4; ++m) { bf16_t* rowp = base + (size_t)(row0 + ai * HALF + m * 16) * ld + col0;
#pragma unroll
                for (int bj = 0; bj < 2; ++bj) { f32x4 v0 = acc[ai][bj][m][0], v1 = acc[ai][bj][m][1];
                    if (ACT == 0) { if (sg) {
#pragma unroll
                        for (int j = 0; j < 4; ++j) { v0[j] = sigm(fmaxf(v0[j], -30.f)); v1[j] = sigm(fmaxf(v1[j], -30.f)); } } }
                    if (ACT == 1) {
#pragma unroll
                        for (int j = 0; j < 4; ++j) { const float a = fmaxf(v0[j], 0.f), b = fmaxf(v1[j], 0.f); v0[j] = a * a; v1[j] = b * b; } }
                    if (ACT == 2) { const f32x4 s0 = *(const f32x4*)(scale + scol0 + bj * HALF), s1 = *(const f32x4*)(scale + scol0 + bj * HALF + 4); v0 = v0 * s0; v1 = v1 * s1; }
                    u32x4 w; w.x = cvt_pk_bf16(v0[0], v0[1]); w.y = cvt_pk_bf16(v0[2], v0[3]); w.z = cvt_pk_bf16(v1[0], v1[1]); w.w = cvt_pk_bf16(v1[2], v1[3]);
                    *(u32x4*)(rowp + bj * HALF) = w; } }
    }
};
struct EpiGlu {
    static constexpr bool PERM = true, AFTER_DRAIN = false, KHOOK = false;
    bf16_t* O; int ldc;
    __device__ __forceinline__ void operator()(f32x4 (&acc)[2][2][4][2], const Unit& u, int wr, int wc, int fr, int fq) const {
        const int row0 = u.pm * BM + wr * 64 + fr, col0 = u.pn * HALF + wc * 32 + 8 * fq;
#pragma unroll
        for (int ai = 0; ai < 2; ++ai)
#pragma unroll
            for (int m = 0; m < 4; ++m) { bf16_t* rowp = O + (size_t)(row0 + ai * HALF + m * 16) * ldc + col0;
                f32x4 v0 = acc[ai][0][m][0], v1 = acc[ai][0][m][1]; const f32x4 g0 = acc[ai][1][m][0], g1 = acc[ai][1][m][1];
#pragma unroll
                for (int j = 0; j < 4; ++j) { v0[j] *= sigm(g0[j]); v1[j] *= sigm(g1[j]); }
                u32x4 w; w.x = cvt_pk_bf16(v0[0], v0[1]); w.y = cvt_pk_bf16(v0[2], v0[3]); w.z = cvt_pk_bf16(v1[0], v1[1]); w.w = cvt_pk_bf16(v1[2], v1[3]);
                *(u32x4*)rowp = w; }
    }
};
struct EpiBranch {
    static constexpr bool PERM = true, AFTER_DRAIN = false, KHOOK = true;
    bf16_t* O; int ldc; const bf16_t* Gt;
    __device__ __forceinline__ void khook(f32x4 (&acc)[2][2][4][2], const Unit& u, int seg, int wr, int wc, int fr, int fq) const {
        int row0 = u.pm * BM + wr * 64 + fr, col0 = u.pn * BM + wc * 32 + 8 * fq;
        asm volatile("" : "+v"(row0), "+v"(col0));
        const bool lastseg = (seg >= 3); const int nxt = lastseg ? 0 : 2048;
#pragma unroll
        for (int ai = 0; ai < 2; ++ai)
#pragma unroll
            for (int m = 0; m < 4; ++m) {
#pragma unroll
                for (int bj = 0; bj < 2; ++bj) { const bf16_t* gp = Gt + (size_t)(row0 + ai * HALF + m * 16) * 8192 + seg * 2048 + col0 + bj * HALF;
                    const u32x4 a = *(const u32x4*)gp; const u32x4 b = *(const u32x4*)(gp + nxt);
                    f32x4 r0 = (f32x4){bf_lo(a.x), bf_hi(a.x), bf_lo(a.y), bf_hi(a.y)}, r1 = (f32x4){bf_lo(a.z), bf_hi(a.z), bf_lo(a.w), bf_hi(a.w)};
                    f32x4 q0 = (f32x4){bf_lo(b.x), bf_hi(b.x), bf_lo(b.y), bf_hi(b.y)}, q1 = (f32x4){bf_lo(b.z), bf_hi(b.z), bf_lo(b.w), bf_hi(b.w)};
#pragma unroll
                    for (int j = 0; j < 4; ++j) { q0[j] = lastseg ? 1.0f : __builtin_amdgcn_rcpf(q0[j]); q1[j] = lastseg ? 1.0f : __builtin_amdgcn_rcpf(q1[j]); }
                    acc[ai][bj][m][0] = acc[ai][bj][m][0] * (r0 * q0); acc[ai][bj][m][1] = acc[ai][bj][m][1] * (r1 * q1); }
                asm volatile("" ::: "memory"); }
    }
    __device__ __forceinline__ void operator()(f32x4 (&acc)[2][2][4][2], const Unit& u, int wr, int wc, int fr, int fq) const {
        khook(acc, u, u.seg, wr, wc, fr, fq);
        if (u.seg != 3) return;
        const int row0 = u.pm * BM + wr * 64 + fr, col0 = u.pn * BM + wc * 32 + 8 * fq;
#pragma unroll
        for (int ai = 0; ai < 2; ++ai)
#pragma unroll
            for (int m = 0; m < 4; ++m) { bf16_t* rowp = O + (size_t)(row0 + ai * HALF + m * 16) * ldc + col0;
#pragma unroll
                for (int bj = 0; bj < 2; ++bj) { const f32x4 v0 = acc[ai][bj][m][0], v1 = acc[ai][bj][m][1];
                    u32x4 w; w.x = cvt_pk_bf16(v0[0], v0[1]); w.y = cvt_pk_bf16(v0[2], v0[3]); w.z = cvt_pk_bf16(v1[0], v1[1]); w.w = cvt_pk_bf16(v1[2], v1[3]);
                    *(u32x4*)(rowp + bj * HALF) = w; } }
    }
};
template <class Epi, class Sched, bool ALIGN_EPI = false, bool SP2 = false>
__device__ __forceinline__ void gemm_phase(PG8_LAS unsigned char* lds, const Gemm g, const Sched& S, const Epi& E, const int wave_in, const int lane_in) {
    int tid = wave_in * 64 + lane_in; asm volatile("" : "+v"(tid));
    const int wid = wave_in, lane = tid & 63, wr = wid >> 2, wc = wid & 3, fr = lane & 15, fq = lane >> 4;
    const int K = g.K, nt = K / BK;
    unsigned voffA[2], voffB[2];
#pragma unroll
    for (int i = 0; i < 2; ++i) { int R, C; stage_rc(tid * 16 + i * 8192, R, C); const int Rb = Epi::PERM ? ((R & ~31) + perm32(R & 31)) : R;
        voffA[i] = (unsigned)(R * g.lda + C) * 2u; voffB[i] = (unsigned)(Rb * g.ldb + C) * 2u; }
    constexpr unsigned kstep = BK * 2;
    const unsigned hstepA = (unsigned)HALF * g.lda * 2u, hstepB = (unsigned)HALF * g.ldb * 2u;
    const unsigned tstepA = 2u * hstepA, tstepB = 2u * hstepB;
    const unsigned pnoff = (unsigned)g.a_pn_off * 2u;
    const unsigned ldsw = (unsigned)wid * 1024u;
    const int aoff = lds_byte(wr * 64 + fr, fq * 8), boff = lds_byte(wc * 32 + fr, fq * 8);
#define PG8_SA(b, h) (((b) * 2 + (h)) * HTB)
#define PG8_SB(b, h) ((4 + (b) * 2 + (h)) * HTB)
#define PG8_STAGE(bufoff, gbase, voff) do { _Pragma("unroll") for (int _i = 0; _i < 2; ++_i) \
        __builtin_amdgcn_global_load_lds((const unsigned*)((const char*)(gbase) + (voff)[_i]), (PG8_LAS unsigned*)(lds + (bufoff) + ldsw + _i * 8192), 16, 0, 0); } while (0)
#define PG8_LDA(dst, b, h) do { _Pragma("unroll") for (int m = 0; m < 4; ++m) _Pragma("unroll") for (int k = 0; k < 2; ++k) dst[m][k] = *(const PG8_LAS bf16x8*)(lds + PG8_SA(b, h) + aoff + m * 2048 + k * 1024); } while (0)
#define PG8_LDB(dst, b, h) do { _Pragma("unroll") for (int n = 0; n < 2; ++n) _Pragma("unroll") for (int k = 0; k < 2; ++k) dst[n][k] = *(const PG8_LAS bf16x8*)(lds + PG8_SB(b, h) + boff + n * 2048 + k * 1024); } while (0)
#define PG8_MMA(ai, bj, At, Bt) do { __builtin_amdgcn_s_setprio(1); _Pragma("unroll") for (int m = 0; m < 4; ++m) _Pragma("unroll") for (int n = 0; n < 2; ++n) _Pragma("unroll") for (int k = 0; k < 2; ++k) \
        acc[ai][bj][m][n] = __builtin_amdgcn_mfma_f32_16x16x32_bf16(Bt[n][k], At[m][k], acc[ai][bj][m][n], 0, 0, 0); __builtin_amdgcn_s_setprio(0); } while (0)
#define PG8_WAIT_V(n) asm volatile("s_waitcnt vmcnt(" #n ")" ::: "memory")
#define PG8_WAIT_L(n) asm volatile("s_waitcnt lgkmcnt(" #n ")" ::: "memory")
#define PG8_BAR __builtin_amdgcn_s_barrier()
#define PG8_SCHED __builtin_amdgcn_sched_barrier(0)
    Unit cur, nxt; int ui = 0;
    if (!S.next(0, cur)) return;
    f32x4 acc[2][2][4][2];
#pragma unroll
    for (int a = 0; a < 2; ++a)
#pragma unroll
        for (int b = 0; b < 2; ++b)
#pragma unroll
            for (int m = 0; m < 4; ++m)
#pragma unroll
                for (int n = 0; n < 2; ++n) acc[a][b][m][n] = (f32x4){0.f, 0.f, 0.f, 0.f};
    bf16x8 At[4][2], B0[2][2], B1[2][2];
    const unsigned segoff = Epi::KHOOK ? (unsigned)K * 2u : 0u;
    const char* cA = (const char*)g.A + ((unsigned)cur.pm * tstepA + (unsigned)cur.pn * pnoff + (unsigned)cur.seg * segoff); const char* cB = (const char*)g.Bt + ((unsigned)cur.pn * tstepB + (unsigned)cur.seg * segoff);
    S.a_ready(cur);
    if constexpr (SP2) {
        PG8_STAGE(PG8_SB(0, 0), cB, voffB); PG8_STAGE(PG8_SB(0, 1), cB + hstepB, voffB); PG8_STAGE(PG8_SA(0, 0), cA, voffA); PG8_STAGE(PG8_SA(0, 1), cA + hstepA, voffA);
        if (wr == 1) PG8_BAR;
        PG8_WAIT_V(2); PG8_BAR;
        PG8_STAGE(PG8_SB(1, 0), cB + kstep, voffB); PG8_STAGE(PG8_SA(1, 0), cA + kstep, voffA); PG8_STAGE(PG8_SB(1, 1), cB + hstepB + kstep, voffB);
        PG8_WAIT_V(6); PG8_BAR;
    } else {
        PG8_STAGE(PG8_SB(0, 0), cB, voffB); PG8_STAGE(PG8_SA(0, 0), cA, voffA); PG8_STAGE(PG8_SB(0, 1), cB + hstepB, voffB); PG8_STAGE(PG8_SA(0, 1), cA + hstepA, voffA);
        if (wr == 1) PG8_BAR;
        PG8_WAIT_V(4); PG8_BAR;
        PG8_STAGE(PG8_SB(1, 0), cB + kstep, voffB); PG8_STAGE(PG8_SA(1, 0), cA + kstep, voffA); PG8_STAGE(PG8_SB(1, 1), cB + hstepB + kstep, voffB);
        PG8_WAIT_V(6); PG8_BAR;
    }
    for (;;) {
        const bool has_next = S.next(ui + 1, nxt);
        const char* nA = has_next ? (const char*)g.A + ((unsigned)nxt.pm * tstepA + (unsigned)nxt.pn * pnoff + (unsigned)nxt.seg * segoff) : cA; const char* nB = has_next ? (const char*)g.Bt + ((unsigned)nxt.pn * tstepB + (unsigned)nxt.seg * segoff) : cB;
        for (int t = 0; t < nt; t += 2) {
            const bool last = (t == nt - 2);
            const char* a1 = cA + (unsigned)(t + 1) * kstep;
            const char* a2 = last ? nA : cA + (unsigned)(t + 2) * kstep; const char* b2 = last ? nB : cB + (unsigned)(t + 2) * kstep;
            const char* a3 = a2 + kstep; const char* b3 = b2 + kstep;
            if (last && has_next) S.a_ready(nxt);
            if constexpr (SP2) {
            PG8_LDB(B0, 0, 0); PG8_LDB(B1, 0, 1); PG8_SCHED; PG8_LDA(At, 0, 0); PG8_STAGE(PG8_SA(1, 1), a1 + hstepA, voffA);
            PG8_WAIT_V(8); PG8_WAIT_L(0); PG8_BAR; PG8_MMA(0, 0, At, B0); PG8_MMA(0, 1, At, B1); PG8_BAR; PG8_SCHED;
            PG8_LDA(At, 0, 1); PG8_STAGE(PG8_SB(0, 0), b2, voffB); PG8_STAGE(PG8_SB(0, 1), b2 + hstepB, voffB); PG8_STAGE(PG8_SA(0, 0), a2, voffA);
            PG8_WAIT_V(8); PG8_WAIT_L(0); PG8_BAR; PG8_MMA(1, 0, At, B0); PG8_MMA(1, 1, At, B1); PG8_BAR; PG8_SCHED;
            PG8_LDB(B0, 1, 0); PG8_LDB(B1, 1, 1); PG8_SCHED; PG8_LDA(At, 1, 0); PG8_STAGE(PG8_SA(0, 1), a2 + hstepA, voffA);
            PG8_WAIT_V(8); PG8_WAIT_L(0); PG8_BAR; PG8_MMA(0, 0, At, B0); PG8_MMA(0, 1, At, B1); PG8_BAR; PG8_SCHED;
            PG8_LDA(At, 1, 1); PG8_STAGE(PG8_SB(1, 0), b3, voffB); PG8_STAGE(PG8_SB(1, 1), b3 + hstepB, voffB); PG8_STAGE(PG8_SA(1, 0), a3, voffA);
            PG8_WAIT_V(8); PG8_WAIT_L(0); PG8_BAR; PG8_MMA(1, 0, At, B0); PG8_MMA(1, 1, At, B1); PG8_BAR; PG8_SCHED;
            } else {
            PG8_LDB(B0, 0, 0); PG8_SCHED; PG8_LDA(At, 0, 0); PG8_STAGE(PG8_SA(1, 1), a1 + hstepA, voffA);
            PG8_WAIT_L(8); PG8_BAR; PG8_WAIT_L(0); PG8_MMA(0, 0, At, B0); PG8_BAR; PG8_SCHED;
            PG8_LDB(B1, 0, 1); PG8_STAGE(PG8_SB(0, 0), b2, voffB);
            PG8_BAR; PG8_WAIT_L(0); PG8_MMA(0, 1, At, B1); PG8_BAR;
            PG8_LDA(At, 0, 1); PG8_STAGE(PG8_SA(0, 0), a2, voffA);
            PG8_BAR; PG8_WAIT_L(0); PG8_MMA(1, 0, At, B0); PG8_BAR; PG8_SCHED;
            PG8_STAGE(PG8_SB(0, 1), b2 + hstepB, voffB);
            PG8_WAIT_V(6); PG8_BAR; PG8_MMA(1, 1, At, B1); PG8_BAR;
            PG8_LDB(B0, 1, 0); PG8_SCHED; PG8_LDA(At, 1, 0); PG8_STAGE(PG8_SA(0, 1), a2 + hstepA, voffA);
            PG8_WAIT_L(8); PG8_BAR; PG8_WAIT_L(0); PG8_MMA(0, 0, At, B0); PG8_BAR; PG8_SCHED;
            PG8_LDB(B1, 1, 1); PG8_STAGE(PG8_SB(1, 0), b3, voffB);
            PG8_BAR; PG8_WAIT_L(0); PG8_MMA(0, 1, At, B1); PG8_BAR;
            PG8_LDA(At, 1, 1); PG8_STAGE(PG8_SA(1, 0), a3, voffA);
            PG8_BAR; PG8_WAIT_L(0); PG8_MMA(1, 0, At, B0); PG8_BAR; PG8_SCHED;
            PG8_STAGE(PG8_SB(1, 1), b3 + hstepB, voffB);
            PG8_WAIT_V(6); PG8_BAR; PG8_MMA(1, 1, At, B1); PG8_BAR;
            }
        }
        if constexpr (ALIGN_EPI) { if (wr == 0) PG8_BAR; }
        if constexpr (!Epi::AFTER_DRAIN) { int l2; asm volatile("v_mbcnt_lo_u32_b32 %0, -1, 0\n\tv_mbcnt_hi_u32_b32 %0, -1, %0" : "=v"(l2)); E(acc, cur, wr, wc, l2 & 15, l2 >> 4); S.done(cur); }
        if (!has_next) break;
        if (!Epi::KHOOK || cur.seg == 3)
#pragma unroll
        for (int a = 0; a < 2; ++a)
#pragma unroll
            for (int b = 0; b < 2; ++b)
#pragma unroll
                for (int m = 0; m < 4; ++m)
#pragma unroll
                    for (int n = 0; n < 2; ++n) acc[a][b][m][n] = (f32x4){0.f, 0.f, 0.f, 0.f};
        cur = nxt; cA = nA; cB = nB; ++ui;
        if constexpr (ALIGN_EPI) { if (wr == 1) PG8_BAR; }
    }
    PG8_WAIT_V(0);
    if constexpr (!ALIGN_EPI) { if (wr == 0) PG8_BAR; }
    PG8_BAR;
    if constexpr (Epi::AFTER_DRAIN) { E.fused(acc, cur, wr, wc, fr, fq, lds, wid, lane); S.done(cur); }
#undef PG8_SA
#undef PG8_SB
#undef PG8_STAGE
#undef PG8_LDA
#undef PG8_LDB
#undef PG8_MMA
#undef PG8_WAIT_V
#undef PG8_WAIT_L
#undef PG8_BAR
#undef PG8_SCHED
}
}

constexpr int DM = 2048, NB = 4, SEQ = 2048, MTOK = NB * SEQ, DEPTH = 2;
constexpr int WBR = 512, INC = 11264, PCOLS = 3072, DFF = 8192;
constexpr float EPS = 1e-6f;
constexpr int NTHREADS = 512, NWAVES = 8;
constexpr int LDS_BYTES = 147456, LDS_ST_OFF = 147392;

constexpr size_t MiB = (size_t)1 << 20;
constexpr size_t WS_WIN = 0, WS_WFF1 = 88 * MiB, WS_WFF2 = 152 * MiB, WS_WO = 216 * MiB, WS_WBR = 232 * MiB, WS_WGLU = 248 * MiB, WS_WPOOL = 250 * MiB, WS_SEND = 251 * MiB;
constexpr size_t WS_BAR = 253 * MiB;
constexpr size_t WS_H = 254 * MiB, WS_P = 286 * MiB, WS_G = 334 * MiB, WS_YS = 462 * MiB, WS_Z = 494 * MiB, WS_POOLED = 502 * MiB, WS_MERGED = 510 * MiB, WS_MIX = 542 * MiB, WS_END = 640 * MiB;
constexpr size_t WS_KMAT = 606 * MiB, WS_W1T = 608 * MiB, WS_W2T = 624 * MiB, WS_L64 = WS_SEND;
constexpr size_t L_WIN = (size_t)INC * DM * 2, L_WFF = (size_t)DFF * DM * 2, L_WSQ = (size_t)DM * DM * 2, L_WGLU = (size_t)1024 * 512 * 2, L_WPOOL = (size_t)512 * 256 * 2;

typedef unsigned short bf16;
#define LAS __attribute__((address_space(3)))
typedef unsigned v4u __attribute__((ext_vector_type(4)));
typedef unsigned v2u __attribute__((ext_vector_type(2)));
typedef float v4f __attribute__((ext_vector_type(4)));
typedef float v2f __attribute__((ext_vector_type(2)));

struct Params { const float* in[29]; float* out; unsigned char* ws; };
typedef const Params __attribute__((address_space(4)))* KP;
__device__ __forceinline__ KP kargs() { KP q = (KP)__builtin_amdgcn_kernarg_segment_ptr(); asm volatile("" : "+s"(q)); return q; }

__device__ __forceinline__ unsigned f2bf(float f) { unsigned u = __float_as_uint(f); return (u + 0x7fffu + ((u >> 16) & 1u)) >> 16; }
__device__ __forceinline__ unsigned pk2(float lo, float hi) { return f2bf(lo) | (f2bf(hi) << 16); }
__device__ __forceinline__ float bflo(unsigned w) { return __uint_as_float(w << 16); }
__device__ __forceinline__ float bfhi(unsigned w) { return __uint_as_float(w & 0xffff0000u); }
__device__ __forceinline__ float bf1(const bf16* p) { return __uint_as_float(((unsigned)*p) << 16); }
__device__ __forceinline__ float sigmoid_f(float x) { return 1.0f / (1.0f + __expf(-x)); }
__device__ __forceinline__ float gelu_tanh(float x) { const float y = 1.5957691216057308f * (x + 0.044715f * x * x * x); return x / (1.0f + __expf(-y)); }
__device__ __forceinline__ float wave_sum(float v, int lane) {
#pragma unroll
    for (int o = 1; o < 64; o <<= 1) v += __builtin_bit_cast(float, __builtin_amdgcn_ds_bpermute((lane ^ o) << 2, __builtin_bit_cast(int, v)));
    return v;
}
#define LDS_WAIT() asm volatile("s_waitcnt lgkmcnt(0)" ::: "memory")

__device__ __forceinline__ void transpose_item(const float* W, int K, int N, bf16* WT, LAS float* scr, int item, int lane, int mode) {
    const int nblk = N / 32, kb = item / nblk, nb = item % nblk, k0 = 64 * kb, n0 = 32 * nb;
    int src0 = n0; if (mode == 1) { const int pn = n0 >> 8, bj = (n0 >> 7) & 1, j0 = n0 & 127; src0 = bj * 512 + pn * 128 + j0; }
#pragma unroll 8
    for (int i = 0; i < 32; ++i) { const int kk = 2 * i + (lane >> 5); scr[kk * 33 + (lane & 31)] = W[(size_t)(k0 + kk) * N + src0 + (lane & 31)]; }
    LDS_WAIT();
    const int c = lane & 7;
#pragma unroll
    for (int j = 0; j < 4; ++j) { const int n = (lane >> 3) + 8 * j; const LAS float* s = scr + (8 * c) * 33 + n;
        v4u o; o.x = pk2(s[0 * 33], s[1 * 33]); o.y = pk2(s[2 * 33], s[3 * 33]); o.z = pk2(s[4 * 33], s[5 * 33]); o.w = pk2(s[6 * 33], s[7 * 33]);
        *(v4u*)(WT + (size_t)(n0 + n) * K + k0 + 8 * c) = o; }
    LDS_WAIT();
}

__device__ __forceinline__ void rms_row_to_bf16(const float* xrow, const float* g, bf16* orow, int lane) {
    const v4f* xr = (const v4f*)xrow + lane; v4f v[8]; float s = 0.f;
#pragma unroll
    for (int j = 0; j < 8; ++j) { v[j] = xr[64 * j]; s += (v[j].x * v[j].x + v[j].y * v[j].y) + (v[j].z * v[j].z + v[j].w * v[j].w); }
    const float r = rsqrtf(wave_sum(s, lane) * (1.f / DM) + EPS);
    const v4f* gr = (const v4f*)g + lane; v2u* o8 = (v2u*)orow + lane;
#pragma unroll
    for (int j = 0; j < 8; ++j) { const v4f gg = gr[64 * j]; v2u o; o.x = pk2(v[j].x * r * gg.x, v[j].y * r * gg.y); o.y = pk2(v[j].z * r * gg.z, v[j].w * r * gg.w); o8[64 * j] = o; }
}
__device__ __forceinline__ void resid_norm_row(const float* yrow, const float* xi, float* xo, const float* g1, const float* g2, bf16* hn, int lane) {
    const v4f* yr = (const v4f*)yrow + lane; const v4f* xr = (const v4f*)xi + lane; v4f v[8]; float s = 0.f;
#pragma unroll
    for (int j = 0; j < 8; ++j) { v[j] = yr[64 * j]; s += (v[j].x * v[j].x + v[j].y * v[j].y) + (v[j].z * v[j].z + v[j].w * v[j].w); }
    const float r = rsqrtf(wave_sum(s, lane) * (1.f / DM) + EPS);
    const v4f* gr = (const v4f*)g1 + lane; v4f* xw = (v4f*)xo + lane; float s2 = 0.f;
#pragma unroll
    for (int j = 0; j < 8; ++j) { const v4f gg = gr[64 * j]; const v4f xx = xr[64 * j]; v[j] = xx + v[j] * r * gg; xw[64 * j] = v[j]; s2 += (v[j].x * v[j].x + v[j].y * v[j].y) + (v[j].z * v[j].z + v[j].w * v[j].w); }
    if (hn) { const float r2 = rsqrtf(wave_sum(s2, lane) * (1.f / DM) + EPS); const v4f* g2r = (const v4f*)g2 + lane; v2u* o8 = (v2u*)hn + lane;
#pragma unroll
        for (int j = 0; j < 8; ++j) { const v4f gg = g2r[64 * j]; v2u o; o.x = pk2(v[j].x * r2 * gg.x, v[j].y * r2 * gg.y); o.y = pk2(v[j].z * r2 * gg.z, v[j].w * r2 * gg.w); o8[64 * j] = o; } }
}

constexpr int SSM_KM_BYTES = 64 * 2 * 16 * 8 * 2;
typedef short bf16x8v __attribute__((ext_vector_type(8)));
__device__ __forceinline__ bf16x8v as_bf8(v4u x) { return __builtin_bit_cast(bf16x8v, x); }

__device__ __forceinline__ void ssm_tables_job(KP p, int l, int g, int tid, unsigned char* ws, LAS unsigned char* lds) {
    LAS float* lm = (LAS float*)lds; LAS float* ang = lm + 64;
    LAS v2f* Bb = (LAS v2f*)(lds + 1024); LAS v2f* Cc = (LAS v2f*)(lds + 1024 + 8192); LAS v2f* Lpow = (LAS v2f*)(lds + 1024 + 16384);
    bf16* W1t = (bf16*)(ws + WS_W1T) + (size_t)(l * 32 + g) * 128 * 1024; bf16* W2t = (bf16*)(ws + WS_W2T) + (size_t)(l * 32 + g) * 1024 * 128;
    bf16* Km = (bf16*)(ws + WS_KMAT) + (size_t)(l * 32 + g) * (SSM_KM_BYTES / 2); v2f* L64 = (v2f*)(ws + WS_L64) + (l * 32 + g) * 64;
    if (tid < 64) { const int n = tid;
        const float ar = p->in[3][(l * 32 + g) * 64 + n], ai = p->in[4][(l * 32 + g) * 64 + n], dt = expf(p->in[5][l * 32 + g]);
        const float lmv = ar * dt, an = ai * dt, mag = expf(lmv), lr = mag * cosf(an), li = mag * sinf(an), den = ar * ar + ai * ai;
        const float fr = ((lr - 1.0f) * ar + li * ai) / den, fi = (li * ar - (lr - 1.0f) * ai) / den;
        lm[n] = lmv; ang[n] = an;
        const float* br = p->in[6] + ((size_t)(l * 32 + g) * 64 + n) * 16; const float* bi = p->in[7] + ((size_t)(l * 32 + g) * 64 + n) * 16;
        for (int q = 0; q < 16; ++q) Bb[n * 16 + q] = (v2f){fr * br[q] - fi * bi[q], fr * bi[q] + fi * br[q]}; }
    for (int i = tid; i < 1024; i += NTHREADS) Cc[i] = (v2f){p->in[8][(size_t)(l * 32 + g) * 1024 + i], p->in[9][(size_t)(l * 32 + g) * 1024 + i]};
    __syncthreads();
    for (int e = tid; e < 65 * 64; e += NTHREADS) { const int m = e >> 6, n = e & 63; const float mg = expf((float)m * lm[n]), a = (float)m * ang[n]; Lpow[e] = (v2f){mg * cosf(a), mg * sinf(a)}; }
    __syncthreads();
    if (tid < 64) L64[tid] = Lpow[64 * 64 + tid];
    for (int e = tid; e < 4096; e += NTHREADS) { const int n = e & 63, tp = e >> 6; const v2f L = Lpow[(63 - tp) * 64 + n];
        unsigned re[8], im[8];
#pragma unroll
        for (int q = 0; q < 8; ++q) { const v2f b0 = Bb[n * 16 + 2 * q], b1 = Bb[n * 16 + 2 * q + 1];
            re[q] = pk2(L.x * b0.x - L.y * b0.y, L.x * b1.x - L.y * b1.y); im[q] = pk2(L.x * b0.y + L.y * b0.x, L.x * b1.y + L.y * b1.x); }
        v4u* o0 = (v4u*)(W1t + (size_t)(2 * n) * 1024 + tp * 16); v4u* o1 = (v4u*)(W1t + (size_t)(2 * n + 1) * 1024 + tp * 16);
        o0[0] = (v4u){re[0], re[1], re[2], re[3]}; o0[1] = (v4u){re[4], re[5], re[6], re[7]}; o1[0] = (v4u){im[0], im[1], im[2], im[3]}; o1[1] = (v4u){im[4], im[5], im[6], im[7]}; }
    for (int e = tid; e < 4096; e += NTHREADS) { const int n = e & 63, t = e >> 6; const v2f L = Lpow[(t + 1) * 64 + n];
        for (int q = 0; q < 16; ++q) { const v2f c = Cc[q * 64 + n]; ((unsigned*)W2t)[((size_t)(t * 16 + q) * 128 + 2 * n) >> 1] = pk2(c.x * L.x - c.y * L.y, -(c.x * L.y + c.y * L.x)); } }
    for (int it = tid; it < 2048; it += NTHREADS) { const int d = it >> 5, pp = (it >> 1) & 15, h = it & 1;
        float acc[8] = {0.f, 0.f, 0.f, 0.f, 0.f, 0.f, 0.f, 0.f};
        for (int n = 0; n < 64; ++n) { const v2f L = Lpow[d * 64 + n], c = Cc[pp * 64 + n]; const float gr = c.x * L.x - c.y * L.y, gi = c.x * L.y + c.y * L.x;
#pragma unroll
            for (int q = 0; q < 8; ++q) { const v2f bb = Bb[n * 16 + 8 * h + q]; acc[q] = fmaf(gr, bb.x, acc[q]); acc[q] = fmaf(-gi, bb.y, acc[q]); } }
        *(v4u*)(Km + (size_t)((d * 2 + h) * 16 + pp) * 8) = (v4u){pk2(acc[0], acc[1]), pk2(acc[2], acc[3]), pk2(acc[4], acc[5]), pk2(acc[6], acc[7])}; }
    __syncthreads();
}

__device__ __forceinline__ void ssm_seq_job(KP p, int l, int job, int tid, int wave, int lane, const bf16* P, bf16* Z, unsigned char* ws, LAS unsigned char* lds) {
    const int g = job & 31, b = job >> 5, fr = lane & 15, fq = lane >> 4;
    LAS unsigned char* KmL = lds; LAS float* S = (LAS float*)(lds + 32768); LAS unsigned char* Cb = lds + 32768 + 32 * 132 * 4; LAS unsigned char* UL = lds + 32768 + 32 * 132 * 4 + 32 * 272;
    { const v4u* src = (const v4u*)(ws + WS_KMAT + (size_t)(l * 32 + g) * SSM_KM_BYTES);
#pragma unroll
      for (int i = 0; i < 4; ++i) *(LAS v4u*)(KmL + (tid + i * NTHREADS) * 16) = src[tid + i * NTHREADS]; }
#pragma unroll
    for (int i = 0; i < 4; ++i) { const int t = tid + i * NTHREADS; const v4u* src = (const v4u*)(P + ((size_t)b * SEQ + t) * PCOLS + g * 16); const v4u x0 = src[0], x1 = src[1];
        LAS v4u* dst = (LAS v4u*)(UL + (t >> 6) * 2064 + (t & 63) * 32); dst[0] = x0; dst[1] = x1; }
    __syncthreads();
    const bf16* W1t = (const bf16*)(ws + WS_W1T) + (size_t)(l * 32 + g) * 128 * 1024; const bf16* W2t = (const bf16*)(ws + WS_W2T) + (size_t)(l * 32 + g) * 1024 * 128;
    const LAS unsigned char* Ub = UL + fr * 2064 + fq * 16;
    pg8::f32x4 acc;
    { v4u w1[32]; const bf16* wb = W1t + (size_t)(16 * wave + fr) * 1024 + 8 * fq;
#pragma unroll
      for (int j = 0; j < 32; ++j) w1[j] = *(const v4u*)(wb + 32 * j);
#pragma unroll
      for (int rbk = 0; rbk < 2; ++rbk) {
        acc = (pg8::f32x4){0.f, 0.f, 0.f, 0.f};
        const LAS unsigned char* ub = Ub + rbk * 16 * 2064;
#pragma unroll
        for (int j = 0; j < 32; ++j) { const v4u a = *(const LAS v4u*)(ub + j * 64);
            acc = __builtin_amdgcn_mfma_f32_16x16x32_bf16(as_bf8(w1[j]), as_bf8(a), acc, 0, 0, 0); }
        *(LAS pg8::f32x4*)(S + (rbk * 16 + fr) * 132 + 16 * wave + 4 * fq) = acc;
      } }
    __syncthreads();
    if (tid < 64) { const v2f L = ((const v2f*)(ws + WS_L64))[(l * 32 + g) * 64 + tid]; float cr = 0.f, ci = 0.f;
        for (int c = 0; c < 32; ++c) { *(LAS unsigned*)(Cb + c * 272 + tid * 4) = pk2(cr, ci);
            const float sr = S[c * 132 + 2 * tid], si = S[c * 132 + 2 * tid + 1]; const float nr = L.x * cr - L.y * ci + sr, ni = L.x * ci + L.y * cr + si; cr = nr; ci = ni; } }
    __syncthreads();
    const float4 dsk = *(const float4*)(p->in[10] + l * 512 + g * 16 + 4 * fq);
#pragma unroll 1
    for (int rbk = 0; rbk < 2; ++rbk) {
        v4u a[32]; const LAS unsigned char* ub = Ub + rbk * 16 * 2064;
#pragma unroll
        for (int j = 0; j < 32; ++j) a[j] = *(const LAS v4u*)(ub + j * 64);
#pragma unroll 1
        for (int i = 0; i < 8; ++i) { const int tau = wave + 8 * i;
            acc = (pg8::f32x4){0.f, 0.f, 0.f, 0.f};
            v4u w2c[4];
#pragma unroll
            for (int j = 0; j < 4; ++j) w2c[j] = *(const v4u*)(W2t + (size_t)(tau * 16 + fr) * 128 + 8 * fq + 32 * j);
#pragma unroll
            for (int j = 0; j < 32; ++j) if (2 * j <= tau) { int dl = tau - 2 * j - (fq >> 1); const bool ok = dl >= 0; dl = ok ? dl : 0;
                v4u kf = *(const LAS v4u*)(KmL + (((dl * 2 + (fq & 1)) * 16 + fr) * 8) * 2); if (!ok) kf = (v4u){0u, 0u, 0u, 0u};
                acc = __builtin_amdgcn_mfma_f32_16x16x32_bf16(as_bf8(kf), as_bf8(a[j]), acc, 0, 0, 0); }
#pragma unroll
            for (int j = 0; j < 4; ++j) { const v4u cfj = *(const LAS v4u*)(Cb + (rbk * 16 + fr) * 272 + (32 * j + 8 * fq) * 2);
                acc = __builtin_amdgcn_mfma_f32_16x16x32_bf16(as_bf8(w2c[j]), as_bf8(cfj), acc, 0, 0, 0); }
            const size_t row = (size_t)b * SEQ + (size_t)(rbk * 16 + fr) * 64 + tau;
            const v2u uu = *(const LAS v2u*)(UL + (rbk * 16 + fr) * 2064 + tau * 32 + 8 * fq);
            const float z0 = gelu_tanh(acc[0] + dsk.x * bflo(uu.x)), z1 = gelu_tanh(acc[1] + dsk.y * bfhi(uu.x)), z2 = gelu_tanh(acc[2] + dsk.z * bflo(uu.y)), z3 = gelu_tanh(acc[3] + dsk.w * bfhi(uu.y));
            *(v2u*)(Z + row * 512 + g * 16 + 4 * fq) = (v2u){pk2(z0, z1), pk2(z2, z3)}; }
    }
    __syncthreads();
}

__device__ __forceinline__ void pool_job(int job, int tid, const bf16* P, bf16* pooled) {
    const int b = job >> 6, t0 = (job & 63) * 32, c = tid, wsel = c >> 7;
    const bf16* U = P + (size_t)b * SEQ * PCOLS + 512 + c;
    float u[47];
#pragma unroll
    for (int i = 0; i < 47; ++i) { const int tt = t0 - 15 + i; u[i] = (tt >= 0) ? bf1(U + (size_t)tt * PCOLS) : 0.f; }
    const int w = 2 << wsel;
#pragma unroll
    for (int i = 0; i < 32; ++i) { const int t = t0 + i;
        const float s2 = u[i + 15] + u[i + 14];
        const float s4 = s2 + (u[i + 13] + u[i + 12]);
        const float s8 = s4 + ((u[i + 11] + u[i + 10]) + (u[i + 9] + u[i + 8]));
        const float s16 = s8 + (((u[i + 7] + u[i + 6]) + (u[i + 5] + u[i + 4])) + ((u[i + 3] + u[i + 2]) + (u[i + 1] + u[i])));
        const float sum = wsel == 0 ? s2 : (wsel == 1 ? s4 : (wsel == 2 ? s8 : s16));
        const int cnt = (t + 1 < w) ? (t + 1) : w;
        pooled[((size_t)b * SEQ + t) * 512 + c] = (bf16)f2bf(sum / (float)cnt - u[i + 15]); }
}

__device__ __forceinline__ void conv_job(KP p, int l, int job, int tid, int wave, int lane, const bf16* P, bf16* ys, LAS unsigned char* lds) {
    const int b = job >> 7, t0 = (job & 127) * 16, c = tid;
    LAS float* Y = (LAS float*)lds;
    float v[46];
    const bf16* base = P + (size_t)b * SEQ * PCOLS + 1024 + c;
#pragma unroll
    for (int j = 0; j < 46; ++j) { const int tt = t0 - 30 + j; float x = 0.f; if (tt >= 0) { const float val = bf1(base + (size_t)tt * PCOLS), gate = bf1(base + (size_t)tt * PCOLS + 512); x = val * sigmoid_f(gate); } v[j] = x; }
    float y[16]; const float cb = p->in[15][l * 512 + c];
#pragma unroll
    for (int t = 0; t < 16; ++t) y[t] = cb;
#pragma unroll
    for (int k = 0; k < 31; ++k) { const float wk = p->in[14][(size_t)(l * 31 + k) * 512 + c];
#pragma unroll
        for (int t = 0; t < 16; ++t) y[t] = fmaf(wk, v[t + k], y[t]); }
#pragma unroll
    for (int t = 0; t < 16; ++t) Y[t * 512 + c] = y[t];
    __syncthreads();
#pragma unroll
    for (int q = 0; q < 2; ++q) { const int t = wave * 2 + q;
        const v4f a = *(const LAS v4f*)(Y + t * 512 + 8 * lane), bq = *(const LAS v4f*)(Y + t * 512 + 8 * lane + 4);
        float x[8] = {a.x, a.y, a.z, a.w, bq.x, bq.y, bq.z, bq.w};
        float s = 0.f;
#pragma unroll
        for (int i = 0; i < 8; ++i) s += x[i];
        const float mu = wave_sum(s, lane) * (1.f / 512.f); float s2 = 0.f;
#pragma unroll
        for (int i = 0; i < 8; ++i) { x[i] -= mu; s2 += x[i] * x[i]; }
        const float rstd = rsqrtf(wave_sum(s2, lane) * (1.f / 512.f) + EPS);
        const float* lg = p->in[16] + l * 512 + 8 * lane; const float* lb = p->in[17] + l * 512 + 8 * lane;
        float o[8];
#pragma unroll
        for (int i = 0; i < 8; ++i) { const float z = x[i] * rstd * lg[i] + lb[i]; o[i] = z * sigmoid_f(z); }
        v4u w; w.x = pk2(o[0], o[1]); w.y = pk2(o[2], o[3]); w.z = pk2(o[4], o[5]); w.w = pk2(o[6], o[7]);
        *(v4u*)(ys + ((size_t)b * SEQ + t0 + t) * DM + 1024 + 8 * lane) = w; }
    __syncthreads();
}

__device__ __forceinline__ void gmlp_job(KP p, int l, int job, int tid, int wave, int lane, const bf16* P, bf16* ys, LAS unsigned char* lds) {
    const int h = job & 3; const size_t row0 = (size_t)(job >> 2) * 128; const int fr = lane & 15, fq = lane >> 4;
    LAS unsigned char* vT = lds;
#pragma unroll 1
    for (int bt = 0; bt < 2; ++bt) { const int s0 = wave * 16 + bt * 8;
        v4u raw[8];
#pragma unroll
        for (int q = 0; q < 8; ++q) raw[q] = *(const v4u*)(P + (row0 + s0 + q) * PCOLS + 2560 + 8 * lane);
        float x[8][8], sm[8];
#pragma unroll
        for (int q = 0; q < 8; ++q) { x[q][0] = bflo(raw[q].x); x[q][1] = bfhi(raw[q].x); x[q][2] = bflo(raw[q].y); x[q][3] = bfhi(raw[q].y); x[q][4] = bflo(raw[q].z); x[q][5] = bfhi(raw[q].z); x[q][6] = bflo(raw[q].w); x[q][7] = bfhi(raw[q].w);
            float a = 0.f;
#pragma unroll
            for (int i = 0; i < 8; ++i) { x[q][i] = gelu_tanh(x[q][i]); a += x[q][i]; }
            sm[q] = a; }
#pragma unroll
        for (int o = 1; o < 64; o <<= 1) {
#pragma unroll
            for (int q = 0; q < 8; ++q) sm[q] += __builtin_bit_cast(float, __builtin_amdgcn_ds_bpermute((lane ^ o) << 2, __builtin_bit_cast(int, sm[q]))); }
#pragma unroll
        for (int q = 0; q < 8; ++q) { const float mu = sm[q] * (1.f / 512.f); float a = 0.f;
#pragma unroll
            for (int i = 0; i < 8; ++i) { x[q][i] -= mu; a += x[q][i] * x[q][i]; }
            sm[q] = a; }
#pragma unroll
        for (int o = 1; o < 64; o <<= 1) {
#pragma unroll
            for (int q = 0; q < 8; ++q) sm[q] += __builtin_bit_cast(float, __builtin_amdgcn_ds_bpermute((lane ^ o) << 2, __builtin_bit_cast(int, sm[q]))); }
        if ((lane >> 4) == h) { const float* lg = p->in[18] + l * 512 + 8 * lane; const float* lb = p->in[19] + l * 512 + 8 * lane;
#pragma unroll
            for (int i = 0; i < 8; ++i) { const float gi = lg[i], bi = lb[i]; const int d = 8 * (lane & 15) + i;
#pragma unroll
                for (int q = 0; q < 8; q += 2) { const float r0 = rsqrtf(sm[q] * (1.f / 512.f) + EPS), r1 = rsqrtf(sm[q + 1] * (1.f / 512.f) + EPS);
                    *(LAS unsigned*)(vT + d * 272 + (s0 + q) * 2) = pk2(x[q][i] * r0 * gi + bi, x[q + 1][i] * r1 * gi + bi); } } }
    }
    __syncthreads();
    const int t = 16 * wave + fr, nks = (wave >> 1) + 1;
    const float* Wsh = p->in[20] + (size_t)(l * 4 + h) * 128 * 128 + (size_t)t * 128; const float bias = p->in[21][(l * 4 + h) * 128 + t];
    v4u af[4];
#pragma unroll
    for (int j = 0; j < 4; ++j) { af[j] = (v4u){0u, 0u, 0u, 0u};
        if (j < nks) { const int sb = 32 * j + 8 * fq; const v4f w0 = *(const v4f*)(Wsh + sb), w1 = *(const v4f*)(Wsh + sb + 4);
            float wv[8] = {w0.x, w0.y, w0.z, w0.w, w1.x, w1.y, w1.z, w1.w};
#pragma unroll
            for (int i = 0; i < 8; ++i) wv[i] = __uint_as_float(__float_as_uint(wv[i]) & ~(unsigned)((t - sb - i) >> 31));
            af[j] = (v4u){pk2(wv[0], wv[1]), pk2(wv[2], wv[3]), pk2(wv[4], wv[5]), pk2(wv[6], wv[7])}; } }
    v2u uu[8];
#pragma unroll
    for (int cb = 0; cb < 8; ++cb) uu[cb] = *(const v2u*)(P + (row0 + t) * PCOLS + 2048 + h * 128 + 16 * cb + 4 * fq);
#pragma unroll
    for (int cb = 0; cb < 8; ++cb) { pg8::f32x4 acc = (pg8::f32x4){0.f, 0.f, 0.f, 0.f};
#pragma unroll
        for (int j = 0; j < 4; ++j) if (j < nks) { const v4u bfr = *(const LAS v4u*)(vT + (16 * cb + fr) * 272 + (32 * j + 8 * fq) * 2);
            acc = __builtin_amdgcn_mfma_f32_16x16x32_bf16(as_bf8(bfr), as_bf8(af[j]), acc, 0, 0, 0); }
        const float o0 = gelu_tanh(bflo(uu[cb].x)) * (acc[0] + bias), o1 = gelu_tanh(bfhi(uu[cb].x)) * (acc[1] + bias), o2 = gelu_tanh(bflo(uu[cb].y)) * (acc[2] + bias), o3 = gelu_tanh(bfhi(uu[cb].y)) * (acc[3] + bias);
        *(v2u*)(ys + (row0 + t) * DM + 1536 + h * 128 + 16 * cb + 4 * fq) = (v2u){pk2(o0, o1), pk2(o2, o3)}; }
    __syncthreads();
}

#define XB_TMO      128
#define XB_XCNT(j)  (256  + 64 * (j))
#define XB_XSUB(j)  (1280 + 64 * (j))
#define XB_XGEN(j)  (2304 + 64 * (j))
#define XB_TOP      3328
#define XB_TOPGEN   3392
#define XCD_BAR_WORDS 3456
#define XB_SPIN_CAP (1u << 18)
__device__ __forceinline__ unsigned xb_ld(unsigned* p)              { return __hip_atomic_load(p, __ATOMIC_RELAXED, __HIP_MEMORY_SCOPE_AGENT); }
__device__ __forceinline__ unsigned xb_add(unsigned* p, unsigned v) { return __hip_atomic_fetch_add(p, v, __ATOMIC_RELAXED, __HIP_MEMORY_SCOPE_AGENT); }
__device__ __forceinline__ unsigned xb_xcc_id() { return (unsigned)__builtin_amdgcn_s_getreg((3 << 11) | 20) & 0xFu; }
#define XB_SPIN(cond, bar) do { unsigned _sp = 0; while (cond) { __builtin_amdgcn_s_sleep(1); \
    if ((++_sp & 255u) == 0u) { if (xb_ld(&(bar)[XB_TMO])) break; if (_sp > XB_SPIN_CAP) { atomicAdd(&(bar)[XB_TMO], 1u); break; } } } } while (0)
__device__ __forceinline__ void xcd_barrier_complete(unsigned* bar, unsigned x, unsigned G, unsigned& nloc, unsigned& nx) {
    unsigned sum, cnt, mine, sp = 0u;
    for (;;) {
        sum = 0u; cnt = 0u; mine = 0u;
#pragma unroll
        for (unsigned j = 0; j < 16; ++j) { const unsigned c = xb_ld(&bar[XB_XCNT(j)]); sum += c; cnt += (c > 0u) ? 1u : 0u; mine = (j == x) ? c : mine; }
        if (sum == G) break;
        __builtin_amdgcn_s_sleep(1);
        if ((++sp & 255u) == 0u) { if (xb_ld(&bar[XB_TMO])) break; if (sp > XB_SPIN_CAP) { atomicAdd(&bar[XB_TMO], 1u); break; } }
    }
    nloc = mine > 0u ? mine : 1u; nx = cnt > 0u ? cnt : 1u;
}
__device__ __forceinline__ void xcd_barrier(unsigned* bar, volatile LAS unsigned* st, bool first, unsigned G) {
    asm volatile("s_waitcnt vmcnt(0)" ::: "memory");
    __syncthreads();
    if (first) {
        const unsigned x = xb_xcc_id();
        __builtin_amdgcn_s_waitcnt(0);
        unsigned nloc = st[0], nx = st[1];
        if (nloc == 0u) { xcd_barrier_complete(bar, x, G, nloc, nx); st[0] = nloc; st[1] = nx; }
        const unsigned old = xb_add(&bar[XB_XSUB(x)], 1u);
        const unsigned gen = old / nloc;
        if (old + 1u == (gen + 1u) * nloc) {
            __builtin_amdgcn_fence(__ATOMIC_RELEASE, "agent");
            asm volatile("s_waitcnt vmcnt(0)" ::: "memory");
            const unsigned og = xb_add(&bar[XB_TOP], 1u);
            const unsigned tg = og / nx;
            if (og + 1u == (tg + 1u) * nx) xb_add(&bar[XB_TOPGEN], 1u);
            else XB_SPIN(xb_ld(&bar[XB_TOPGEN]) == tg, bar);
            __builtin_amdgcn_fence(__ATOMIC_ACQUIRE, "agent");
            xb_add(&bar[XB_XGEN(x)], 1u);
            asm volatile("s_waitcnt vmcnt(0)" ::: "memory");
        } else {
            XB_SPIN(xb_ld(&bar[XB_XGEN(x)]) == gen, bar);
            __builtin_amdgcn_fence(__ATOMIC_ACQUIRE, "agent");
            asm volatile("s_waitcnt vmcnt(0)" ::: "memory");
        }
    }
    __syncthreads();
}

#ifndef PHMASK
#define PHMASK 0xFFFFFFFFu
#endif
#ifndef JOBMASK
#define JOBMASK 0xFu
#endif
#ifndef PHREP
#define PHREP 0u
#endif
#define NREP(k) (1 + (int)((PHREP >> (k)) & 1u))
#define PH_BEGIN() KP p = kargs(); int wave = wave_s; asm volatile("" : "+s"(wave)); int lane; asm volatile("v_mbcnt_lo_u32_b32 %0, -1, 0\n\tv_mbcnt_hi_u32_b32 %0, -1, %0" : "=v"(lane)); const int tid = wave * 64 + lane; \
    int bid = blockIdx.x, G = gridDim.x; asm volatile("" : "+s"(bid), "+s"(G)); const int gw = bid * NWAVES + wave, NGW = G * NWAVES; unsigned char* ws = p->ws; (void)lane; (void)gw; (void)NGW; (void)ws
#define GRID_BAR() do { KP q_ = kargs(); int w_ = wave_s; asm volatile("" : "+s"(w_)); int l_; asm volatile("v_mbcnt_lo_u32_b32 %0, -1, 0\n\tv_mbcnt_hi_u32_b32 %0, -1, %0" : "=v"(l_)); \
    xcd_barrier((unsigned*)(q_->ws + WS_BAR), (volatile LAS unsigned*)(lds + LDS_ST_OFF), (w_ == 0 && l_ == 0), (unsigned)gridDim.x); } while (0)
__global__ void __launch_bounds__(NTHREADS, 2) hybrid_fwd(Params p_unused) {
    extern __shared__ __attribute__((aligned(16))) unsigned char lds_raw[];
    LAS unsigned char* lds = (LAS unsigned char*)lds_raw;
    cg::grid_group grid = cg::this_grid();
    const int wave_s = __builtin_amdgcn_readfirstlane((int)threadIdx.x >> 6);

    { PH_BEGIN(); if (tid < 2) ((LAS unsigned*)(lds + LDS_ST_OFF))[tid] = 0u;
      if (bid == 0) for (int i = tid; i < XCD_BAR_WORDS; i += NTHREADS) ((unsigned*)(ws + WS_BAR))[i] = 0u; }
    if (PHMASK & (1u << 0)) { PH_BEGIN();
        LAS float* scr = (LAS float*)(lds + wave * 16384);
        constexpr int I_IN = (DM / 64) * (INC / 32), I_FF1 = (DM / 64) * (DFF / 32), I_FF2 = (DFF / 64) * (DM / 32), I_SQ = (DM / 64) * (DM / 32), I_GLU = (512 / 64) * (1024 / 32);
        constexpr int PER_L = I_IN + I_FF1 + I_FF2 + 2 * I_SQ + I_GLU;
        for (int it0 = gw; it0 < DEPTH * PER_L * NREP(0); it0 += NGW) { const int it = it0 % (DEPTH * PER_L);
            const int l = it / PER_L; int r = it % PER_L;
            if (r < I_IN) { transpose_item(p->in[2] + (size_t)l * DM * INC, DM, INC, (bf16*)(ws + WS_WIN + l * L_WIN), scr, r, lane, 0); continue; } r -= I_IN;
            if (r < I_FF1) { transpose_item(p->in[26] + (size_t)l * DM * DFF, DM, DFF, (bf16*)(ws + WS_WFF1 + l * L_WFF), scr, r, lane, 0); continue; } r -= I_FF1;
            if (r < I_FF2) { transpose_item(p->in[27] + (size_t)l * DFF * DM, DFF, DM, (bf16*)(ws + WS_WFF2 + l * L_WFF), scr, r, lane, 0); continue; } r -= I_FF2;
            if (r < I_SQ) { transpose_item(p->in[23] + (size_t)l * DM * DM, DM, DM, (bf16*)(ws + WS_WO + l * L_WSQ), scr, r, lane, 0); continue; } r -= I_SQ;
            if (r < I_SQ) { transpose_item(p->in[22] + (size_t)l * DM * DM, DM, DM, (bf16*)(ws + WS_WBR + l * L_WSQ), scr, r, lane, 0); continue; } r -= I_SQ;
            transpose_item(p->in[11] + (size_t)l * 512 * 1024, 512, 1024, (bf16*)(ws + WS_WGLU + l * L_WGLU), scr, r, lane, 1);
        }
        __syncthreads();
        for (int j = G - 1 - bid; j < DEPTH * 32; j += G) ssm_tables_job(p, j >> 5, j & 31, tid, ws, lds);
        for (int i = bid * NTHREADS + tid; i < DEPTH * 512 * 256; i += G * NTHREADS) { const int l = i / (512 * 256), r = i % (512 * 256), n = r >> 8, kk = r & 255, g = n >> 7, d = n & 127, cc = kk - 128 * (g & 1);
            const float v = (cc >= 0 && cc < 128) ? p->in[12][((size_t)(l * 4 + g) * 128 + cc) * 128 + d] : 0.f;
            ((bf16*)(ws + WS_WPOOL + l * L_WPOOL))[r] = (bf16)f2bf(v); }
        for (int m = gw; m < MTOK; m += NGW) rms_row_to_bf16(p->in[0] + (size_t)m * DM, p->in[1], (bf16*)(ws + WS_H) + (size_t)m * DM, lane);
    }
    grid.sync();
    { PH_BEGIN(); if (tid == 0) (void)xb_add(&((unsigned*)(ws + WS_BAR))[XB_XCNT(xb_xcc_id())], 1u); }

#pragma unroll 1
    for (int l = 0; l < DEPTH; ++l) {
        if (PHMASK & (1u << 1)) { PH_BEGIN();
          pg8::Gemm g{(const bf16*)(ws + WS_H), (const bf16*)(ws + WS_WIN + l * L_WIN), MTOK, INC, DM, DM, DM, 0}; pg8::StaticOrder S; S.init(MTOK, INC, G, bid); S.reps = NREP(1);
          pg8::EpiBf16<0> E{(bf16*)(ws + WS_P), PCOLS, (bf16*)(ws + WS_G), 8192, nullptr, 0};
          pg8::gemm_phase<pg8::EpiBf16<0>, pg8::StaticOrder, true, true>(lds, g, S, E, wave, lane); }
        GRID_BAR();
        if (PHMASK & (1u << 2)) { PH_BEGIN();
          const bf16* Pb = (const bf16*)(ws + WS_P); bf16* YS = (bf16*)(ws + WS_YS);
          for (int j0 = bid; j0 < (128 + 256 + 512 + 256) * NREP(2); j0 += G) { const int j = j0 % (128 + 256 + 512 + 256);
            if (j < 128) { if (JOBMASK & 1u) ssm_seq_job(p, l, j, tid, wave, lane, Pb, (bf16*)(ws + WS_Z), ws, lds); }
            else if (j < 384) { if (JOBMASK & 2u) gmlp_job(p, l, j - 128, tid, wave, lane, Pb, YS, lds); }
            else if (j < 896) { if (JOBMASK & 4u) conv_job(p, l, j - 384, tid, wave, lane, Pb, YS, lds); }
            else { if (JOBMASK & 8u) pool_job(j - 896, tid, Pb, (bf16*)(ws + WS_POOLED)); }
          } }
        GRID_BAR();
        if (PHMASK & (1u << 4)) { PH_BEGIN();
          const bool split = (G >= 192);
          pg8::Gemm g{(const bf16*)(ws + WS_Z), (const bf16*)(ws + WS_WGLU + l * L_WGLU), MTOK, 1024, 512, 512, 512, 0}; pg8::StaticOrder S; S.init(MTOK, 1024, split ? 128 : G, split ? (bid < 128 ? bid : -1) : bid); S.reps = NREP(4);
          pg8::EpiGlu E{(bf16*)(ws + WS_YS), DM};
          pg8::gemm_phase<pg8::EpiGlu, pg8::StaticOrder, true, true>(lds, g, S, E, wave, lane); }
        if (PHMASK & (1u << 4)) { PH_BEGIN();
          const bool split = (G >= 192);
          pg8::Gemm g{(const bf16*)(ws + WS_POOLED), (const bf16*)(ws + WS_WPOOL + l * L_WPOOL), MTOK, 512, 256, 512, 256, 256}; pg8::StaticOrder S; S.init(MTOK, 512, split ? 64 : G, split ? ((bid >= 128 && bid < 192) ? bid - 128 : -1) : bid); S.reps = NREP(4);
          pg8::EpiBf16<2> E{(bf16*)(ws + WS_YS), DM, nullptr, 0, p->in[13] + l * 512, 512};
          pg8::gemm_phase<pg8::EpiBf16<2>, pg8::StaticOrder, true, true>(lds, g, S, E, wave, lane); }
        GRID_BAR();
        if (PHMASK & (1u << 5)) { PH_BEGIN();
          pg8::Gemm g{(const bf16*)(ws + WS_YS), (const bf16*)(ws + WS_WBR + l * L_WSQ), MTOK, DM, 512, DM, DM, 0}; pg8::SegOrder S; S.init(MTOK, DM, G, bid); S.reps = NREP(5);
          pg8::EpiBranch E{(bf16*)(ws + WS_MERGED), DM, (const bf16*)(ws + WS_G)};
          pg8::gemm_phase<pg8::EpiBranch, pg8::SegOrder, true, true>(lds, g, S, E, wave, lane); }
        GRID_BAR();
        if (PHMASK & (1u << 6)) { PH_BEGIN();
          pg8::Gemm g{(const bf16*)(ws + WS_MERGED), (const bf16*)(ws + WS_WO + l * L_WSQ), MTOK, DM, DM, DM, DM, 0}; pg8::StaticOrder S; S.init(MTOK, DM, G, bid); S.reps = NREP(6);
          pg8::EpiF32 E{(float*)(ws + WS_MIX), DM};
          pg8::gemm_phase<pg8::EpiF32, pg8::StaticOrder, true, true>(lds, g, S, E, wave, lane); }
        GRID_BAR();
        if (PHMASK & (1u << 7)) { PH_BEGIN();
          const float* xin = (l == 0) ? p->in[0] : p->out; float* xo = p->out; const float* MIX = (const float*)(ws + WS_MIX); bf16* Hb = (bf16*)(ws + WS_H);
          for (int m = gw; m < MTOK; m += NGW) resid_norm_row(MIX + (size_t)m * DM, xin + (size_t)m * DM, xo + (size_t)m * DM, p->in[24] + l * DM, p->in[25] + l * DM, Hb + (size_t)m * DM, lane); }
        GRID_BAR();
        if (PHMASK & (1u << 8)) { PH_BEGIN();
          pg8::Gemm g{(const bf16*)(ws + WS_H), (const bf16*)(ws + WS_WFF1 + l * L_WFF), MTOK, DFF, DM, DM, DM, 0}; pg8::StaticOrder S; S.init(MTOK, DFF, G, bid); S.reps = NREP(8);
          pg8::EpiBf16<1> E{(bf16*)(ws + WS_G), DFF, nullptr, 0, nullptr, 0};
          pg8::gemm_phase<pg8::EpiBf16<1>, pg8::StaticOrder, true, true>(lds, g, S, E, wave, lane); }
        GRID_BAR();
        if (PHMASK & (1u << 9)) { PH_BEGIN();
          pg8::Gemm g{(const bf16*)(ws + WS_G), (const bf16*)(ws + WS_WFF2 + l * L_WFF), MTOK, DM, DFF, DFF, DFF, 0}; pg8::StaticOrder S; S.init(MTOK, DM, G, bid); S.reps = NREP(9);
          pg8::EpiF32 E{(float*)(ws + WS_MIX), DM};
          pg8::gemm_phase<pg8::EpiF32, pg8::StaticOrder, true, true>(lds, g, S, E, wave, lane); }
        GRID_BAR();
        if (PHMASK & (1u << 10)) { PH_BEGIN();
          const bool more = (l + 1 < DEPTH); float* xo = p->out; const float* MIX = (const float*)(ws + WS_MIX); bf16* Hb = (bf16*)(ws + WS_H);
          for (int m = gw; m < MTOK; m += NGW) resid_norm_row(MIX + (size_t)m * DM, xo + (size_t)m * DM, xo + (size_t)m * DM, p->in[28] + l * DM, more ? p->in[1] + (l + 1) * DM : nullptr, more ? Hb + (size_t)m * DM : nullptr, lane); }
        if (l + 1 < DEPTH) GRID_BAR();
    }
}

extern "C" void kernel_launch(void* const* d_in, const int* in_sizes, int n_in, void* d_out, int out_size, void* d_ws, size_t ws_size, hipStream_t stream) {
    static int grid = 0;
    if (grid == 0) {
        if (n_in != 29 || out_size != MTOK * DM || ws_size < WS_END) { fprintf(stderr, "kernel_launch: unexpected shapes (n_in %d, out %d, ws %zu < %zu)\n", n_in, out_size, ws_size, (size_t)WS_END); grid = -1; return; }
        int dev = 0, cus = 0, per_cu = 0;
        if (hipGetDevice(&dev) != hipSuccess || hipDeviceGetAttribute(&cus, hipDeviceAttributeMultiprocessorCount, dev) != hipSuccess) { grid = -1; return; }
        if (hipFuncSetAttribute((const void*)hybrid_fwd, hipFuncAttributeMaxDynamicSharedMemorySize, LDS_BYTES) != hipSuccess) { fprintf(stderr, "kernel_launch: hipFuncSetAttribute failed\n"); grid = -1; return; }
        if (hipOccupancyMaxActiveBlocksPerMultiprocessor(&per_cu, (const void*)hybrid_fwd, NTHREADS, LDS_BYTES) != hipSuccess || per_cu < 1) { fprintf(stderr, "kernel_launch: occupancy query says %d blocks/CU\n", per_cu); (void)hipGetLastError(); grid = -1; return; }
        grid = cus * per_cu; if (grid > 256) grid = 256;
    }
    if (grid < 0) return;
    Params p{};
    for (int i = 0; i < 29; ++i) p.in[i] = (const float*)d_in[i];
    p.out = (float*)d_out; p.ws = (unsigned char*)d_ws;
    void* args[] = {&p};
    hipError_t e = hipLaunchCooperativeKernel((const void*)hybrid_fwd, dim3(grid), dim3(NTHREADS), args, LDS_BYTES, stream);
    if (e != hipSuccess) fprintf(stderr, "cooperative launch failed: %s (grid %d)\n", hipGetErrorString(e), grid);
}
```

```cpp
#include <hip/hip_runtime.h>
#include <hip/hip_cooperative_groups.h>
#include <cstdio>
#include <cstdint>
namespace cg = cooperative_groups;

namespace pg8 {
#define PG8_LAS __attribute__((address_space(3)))
typedef unsigned short bf16_t;
typedef short bf16x8 __attribute__((ext_vector_type(8)));
typedef float f32x4 __attribute__((ext_vector_type(4)));
typedef unsigned u32x4 __attribute__((ext_vector_type(4)));
typedef unsigned u32x2 __attribute__((ext_vector_type(2)));
constexpr int BM = 256, BK = 64, HALF = 128, HTB = HALF * BK * 2  , STAGE_BYTES = 8 * HTB, NXCD = 8, WGM = 8;

__host__ __device__ __forceinline__ int lds_byte(int r, int c) { const int st = (r >> 4) * 2 + (c >> 5), rr = r & 15, cc = c & 31, ob = rr * 64 + cc * 2; return st * 1024 + (ob ^ (((ob >> 9) & 1) << 5)); }
__host__ __device__ __forceinline__ void stage_rc(int b, int& R, int& C) { const int st = b / 1024, sb = b % 1024, swz = sb ^ (((sb >> 9) & 1) << 5); R = (st >> 1) * 16 + swz / 64; C = (st & 1) * 32 + (swz % 64) / 2; }
__host__ __device__ __forceinline__ int perm32(int rho) { const int n = rho >> 4, i = rho & 15; return 8 * (i >> 2) + 4 * n + (i & 3); }

struct Unit { int pm, pn, seg; };
struct Gemm { const bf16_t* A; const bf16_t* Bt; int M, N, K, lda, ldb, a_pn_off; };

struct StaticOrder {
    int nM, nN, nwg, G, c, reps;
    __host__ __device__ void init(int M, int N, int G_, int c_) { nM = M / BM; nN = N / BM; nwg = nM * nN; G = G_; c = c_; reps = 1; }
    __host__ __device__ bool next(int i, Unit& u) const {
        if (c < 0 || c >= nwg) return false; { const int nc = (nwg - c + G - 1) / G; if (i >= reps * nc) return false; i = i % nc; }
        const long L = (long)i * G + c;
        int wgid = (int)L; { const int q = nwg / NXCD, r = nwg % NXCD, xcd = wgid % NXCD, off = wgid / NXCD; wgid = (xcd < r ? xcd * (q + 1) : r * (q + 1) + (xcd - r) * q) + off; }
        const int nig = WGM * nN, gid = wgid / nig, fm = gid * WGM, gsz = (nM - fm) < WGM ? (nM - fm) : WGM;
        u.pm = fm + ((wgid % nig) % gsz); u.pn = (wgid % nig) / gsz; u.seg = 0; return true;
    }
    __device__ __forceinline__ void a_ready(const Unit&) const {}
    __device__ __forceinline__ void done(const Unit&) const {}
};
struct SegOrder : StaticOrder {
    __host__ __device__ bool next(int i, Unit& u) const { if (!StaticOrder::next(i >> 2, u)) return false; u.seg = i & 3; return true; }
};

__device__ __forceinline__ unsigned cvt_pk_bf16(float lo, float hi) { unsigned r; asm volatile("v_cvt_pk_bf16_f32 %0, %1, %2" : "=v"(r) : "v"(lo), "v"(hi)); return r; }
__device__ __forceinline__ float bf_lo(unsigned w) { return __uint_as_float(w << 16); }
__device__ __forceinline__ float bf_hi(unsigned w) { return __uint_as_float(w & 0xffff0000u); }
__device__ __forceinline__ float sigm(float x) { return __builtin_amdgcn_rcpf(1.0f + __expf(-x)); }

struct EpiF32 {
    static constexpr bool PERM = false, AFTER_DRAIN = false, KHOOK = false;
    float* C; int ldc;
    __device__ __forceinline__ void operator()(f32x4 (&acc)[2][2][4][2], const Unit& u, int wr, int wc, int fr, int fq) const {
        const int row0 = u.pm * BM + wr * 64 + fr, col0 = u.pn * BM + wc * 32 + 4 * fq;
#pragma unroll
        for (int ai = 0; ai < 2; ++ai)
#pragma unroll
            for (int m = 0; m < 4; ++m) { float* rowp = C + (size_t)(row0 + ai * HALF + m * 16) * ldc + col0;
#pragma unroll
                for (int bj = 0; bj < 2; ++bj)
#pragma unroll
                    for (int n = 0; n < 2; ++n) *(f32x4*)(rowp + bj * HALF + n * 16) = acc[ai][bj][m][n]; }
    }
};
template <int ACT> struct EpiBf16 {
    static constexpr bool PERM = true, AFTER_DRAIN = false, KHOOK = false;
    bf16_t* O; int ldc; bf16_t* O2; int ldc2; const float* scale; int coff;
    __device__ __forceinline__ void operator()(f32x4 (&acc)[2][2][4][2], const Unit& u, int wr, int wc, int fr, int fq) const {
        const int row0 = u.pm * BM + wr * 64 + fr; int colt = u.pn * BM; bf16_t* base = O; int ld = ldc; bool sg = false;
        if (ACT == 0 && u.pn >= 12) { base = O2; ld = ldc2; colt -= 12 * BM; sg = true; }
        const int col0 = colt + wc * 32 + 8 * fq + (ACT == 2 ? coff : 0), scol0 = u.pn * BM + wc * 32 + 8 * fq;
#pragma unroll
        for (int ai = 0; ai < 2; ++ai)
#pragma unroll
            for (int m = 0; m < 4; ++m) { bf16_t* rowp = base + (size_t)(row0 + ai * HALF + m * 16) * ld + col0;
#pragma unroll
                for (int bj = 0; bj < 2; ++bj) { f32x4 v0 = acc[ai][bj][m][0], v1 = acc[ai][bj][m][1];
                    if (ACT == 0) { if (sg) {
#pragma unroll
                        for (int j = 0; j < 4; ++j) { v0[j] = sigm(fmaxf(v0[j], -30.f)); v1[j] = sigm(fmaxf(v1[j], -30.f)); } } }
                    if (ACT == 1) {
#pragma unroll
                        for (int j = 0; j < 4; ++j) { const float a = fmaxf(v0[j], 0.f), b = fmaxf(v1[j], 0.f); v0[j] = a * a; v1[j] = b * b; } }
                    if (ACT == 2) { const f32x4 s0 = *(const f32x4*)(scale + scol0 + bj * HALF), s1 = *(const f32x4*)(scale + scol0 + bj * HALF + 4); v0 = v0 * s0; v1 = v1 * s1; }
                    u32x4 w; w.x = cvt_pk_bf16(v0[0], v0[1]); w.y = cvt_pk_bf16(v0[2], v0[3]); w.z = cvt_pk_bf16(v1[0], v1[1]); w.w = cvt_pk_bf16(v1[2], v1[3]);
                    *(u32x4*)(rowp + bj * HALF) = w; } }
    }
};
struct EpiGlu {
    static constexpr bool PERM = true, AFTER_DRAIN = false, KHOOK = false;
    bf16_t* O; int ldc;
    __device__ __forceinline__ void operator()(f32x4 (&acc)[2][2][4][2], const Unit& u, int wr, int wc, int fr, int fq) const {
        const int row0 = u.pm * BM + wr * 64 + fr, col0 = u.pn * HALF + wc * 32 + 8 * fq;
#pragma unroll
        for (int ai = 0; ai < 2; ++ai)
#pragma unroll
            for (int m = 0; m < 4; ++m) { bf16_t* rowp = O + (size_t)(row0 + ai * HALF + m * 16) * ldc + col0;
                f32x4 v0 = acc[ai][0][m][0], v1 = acc[ai][0][m][1]; const f32x4 g0 = acc[ai][1][m][0], g1 = acc[ai][1][m][1];
#pragma unroll
                for (int j = 0; j < 4; ++j) { v0[j] *= sigm(g0[j]); v1[j] *= sigm(g1[j]); }
                u32x4 w; w.x = cvt_pk_bf16(v0[0], v0[1]); w.y = cvt_pk_bf16(v0[2], v0[3]); w.z = cvt_pk_bf16(v1[0], v1[1]); w.w = cvt_pk_bf16(v1[2], v1[3]);
                *(u32x4*)rowp = w; }
    }
};
struct EpiBranch {
    static constexpr bool PERM = true, AFTER_DRAIN = false, KHOOK = true;
    bf16_t* O; int ldc; const bf16_t* Gt;
    __device__ __forceinline__ void khook(f32x4 (&acc)[2][2][4][2], const Unit& u, int seg, int wr, int wc, int fr, int fq) const {
        int row0 = u.pm * BM + wr * 64 + fr, col0 = u.pn * BM + wc * 32 + 8 * fq;
        asm volatile("" : "+v"(row0), "+v"(col0));
        const bool lastseg = (seg >= 3); const int nxt = lastseg ? 0 : 2048;
#pragma unroll
        for (int ai = 0; ai < 2; ++ai)
#pragma unroll
            for (int m = 0; m < 4; ++m) {
#pragma unroll
                for (int bj = 0; bj < 2; ++bj) { const bf16_t* gp = Gt + (size_t)(row0 + ai * HALF + m * 16) * 8192 + seg * 2048 + col0 + bj * HALF;
                    const u32x4 a = *(const u32x4*)gp; const u32x4 b = *(const u32x4*)(gp + nxt);
                    f32x4 r0 = (f32x4){bf_lo(a.x), bf_hi(a.x), bf_lo(a.y), bf_hi(a.y)}, r1 = (f32x4){bf_lo(a.z), bf_hi(a.z), bf_lo(a.w), bf_hi(a.w)};
                    f32x4 q0 = (f32x4){bf_lo(b.x), bf_hi(b.x), bf_lo(b.y), bf_hi(b.y)}, q1 = (f32x4){bf_lo(b.z), bf_hi(b.z), bf_lo(b.w), bf_hi(b.w)};
#pragma unroll
                    for (int j = 0; j < 4; ++j) { q0[j] = lastseg ? 1.0f : __builtin_amdgcn_rcpf(q0[j]); q1[j] = lastseg ? 1.0f : __builtin_amdgcn_rcpf(q1[j]); }
                    acc[ai][bj][m][0] = acc[ai][bj][m][0] * (r0 * q0); acc[ai][bj][m][1] = acc[ai][bj][m][1] * (r1 * q1); }
                asm volatile("" ::: "memory"); }
    }
    __device__ __forceinline__ void operator()(f32x4 (&acc)[2][2][4][2], const Unit& u, int wr, int wc, int fr, int fq) const {
        khook(acc, u, u.seg, wr, wc, fr, fq);
        if (u.seg != 3) return;
        const int row0 = u.pm * BM + wr * 64 + fr, col0 = u.pn * BM + wc * 32 + 8 * fq;
#pragma unroll
        for (int ai = 0; ai < 2; ++ai)
#pragma unroll
            for (int m = 0; m < 4; ++m) { bf16_t* rowp = O + (size_t)(row0 + ai * HALF + m * 16) * ldc + col0;
#pragma unroll
                for (int bj = 0; bj < 2; ++bj) { const f32x4 v0 = acc[ai][bj][m][0], v1 = acc[ai][bj][m][1];
                    u32x4 w; w.x = cvt_pk_bf16(v0[0], v0[1]); w.y = cvt_pk_bf16(v0[2], v0[3]); w.z = cvt_pk_bf16(v1[0], v1[1]); w.w = cvt_pk_bf16(v1[2], v1[3]);
                    *(u32x4*)(rowp + bj * HALF) = w; } }
    }
};
template <class Epi, class Sched, bool ALIGN_EPI = false, bool SP2 = false>
__device__ __forceinline__ void gemm_phase(PG8_LAS unsigned char* lds, const Gemm g, const Sched& S, const Epi& E, const int wave_in, const int lane_in) {
    int tid = wave_in * 64 + lane_in; asm volatile("" : "+v"(tid));
    const int wid = wave_in, lane = tid & 63, wr = wid >> 2, wc = wid & 3, fr = lane & 15, fq = lane >> 4;
    const int K = g.K, nt = K / BK;
    unsigned voffA[2], voffB[2];
#pragma unroll
    for (int i = 0; i < 2; ++i) { int R, C; stage_rc(tid * 16 + i * 8192, R, C); const int Rb = Epi::PERM ? ((R & ~31) + perm32(R & 31)) : R;
        voffA[i] = (unsigned)(R * g.lda + C) * 2u; voffB[i] = (unsigned)(Rb * g.ldb + C) * 2u; }
    constexpr unsigned kstep = BK * 2;
    const unsigned hstepA = (unsigned)HALF * g.lda * 2u, hstepB = (unsigned)HALF * g.ldb * 2u;
    const unsigned tstepA = 2u * hstepA, tstepB = 2u * hstepB;
    const unsigned pnoff = (unsigned)g.a_pn_off * 2u;
    const unsigned ldsw = (unsigned)wid * 1024u;
    const int aoff = lds_byte(wr * 64 + fr, fq * 8), boff = lds_byte(wc * 32 + fr, fq * 8);
#define PG8_SA(b, h) (((b) * 2 + (h)) * HTB)
#define PG8_SB(b, h) ((4 + (b) * 2 + (h)) * HTB)
#define PG8_STAGE(bufoff, gbase, voff) do { _Pragma("unroll") for (int _i = 0; _i < 2; ++_i) \
        __builtin_amdgcn_global_load_lds((const unsigned*)((const char*)(gbase) + (voff)[_i]), (PG8_LAS unsigned*)(lds + (bufoff) + ldsw + _i * 8192), 16, 0, 0); } while (0)
#define PG8_LDA(dst, b, h) do { _Pragma("unroll") for (int m = 0; m < 4; ++m) _Pragma("unroll") for (int k = 0; k < 2; ++k) dst[m][k] = *(const PG8_LAS bf16x8*)(lds + PG8_SA(b, h) + aoff + m * 2048 + k * 1024); } while (0)
#define PG8_LDB(dst, b, h) do { _Pragma("unroll") for (int n = 0; n < 2; ++n) _Pragma("unroll") for (int k = 0; k < 2; ++k) dst[n][k] = *(const PG8_LAS bf16x8*)(lds + PG8_SB(b, h) + boff + n * 2048 + k * 1024); } while (0)
#define PG8_MMA(ai, bj, At, Bt) do { __builtin_amdgcn_s_setprio(1); _Pragma("unroll") for (int m = 0; m < 4; ++m) _Pragma("unroll") for (int n = 0; n < 2; ++n) _Pragma("unroll") for (int k = 0; k < 2; ++k) \
        acc[ai][bj][m][n] = __builtin_amdgcn_mfma_f32_16x16x32_bf16(Bt[n][k], At[m][k], acc[ai][bj][m][n], 0, 0, 0); __builtin_amdgcn_s_setprio(0); } while (0)
#define PG8_WAIT_V(n) asm volatile("s_waitcnt vmcnt(" #n ")" ::: "memory")
#define PG8_WAIT_L(n) asm volatile("s_waitcnt lgkmcnt(" #n ")" ::: "memory")
#define PG8_BAR __builtin_amdgcn_s_barrier()
#define PG8_SCHED __builtin_amdgcn_sched_barrier(0)
    Unit cur, nxt; int ui = 0;
    if (!S.next(0, cur)) return;
    f32x4 acc[2][2][4][2];
#pragma unroll
    for (int a = 0; a < 2; ++a)
#pragma unroll
        for (int b = 0; b < 2; ++b)
#pragma unroll
            for (int m = 0; m < 4; ++m)
#pragma unroll
                for (int n = 0; n < 2; ++n) acc[a][b][m][n] = (f32x4){0.f, 0.f, 0.f, 0.f};
    bf16x8 At[4][2], B0[2][2], B1[2][2];
    const unsigned segoff = Epi::KHOOK ? (unsigned)K * 2u : 0u;
    const char* cA = (const char*)g.A + ((unsigned)cur.pm * tstepA + (unsigned)cur.pn * pnoff + (unsigned)cur.seg * segoff); const char* cB = (const char*)g.Bt + ((unsigned)cur.pn * tstepB + (unsigned)cur.seg * segoff);
    S.a_ready(cur);
    if constexpr (SP2) {
        PG8_STAGE(PG8_SB(0, 0), cB, voffB); PG8_STAGE(PG8_SB(0, 1), cB + hstepB, voffB); PG8_STAGE(PG8_SA(0, 0), cA, voffA); PG8_STAGE(PG8_SA(0, 1), cA + hstepA, voffA);
        if (wr == 1) PG8_BAR;
        PG8_WAIT_V(2); PG8_BAR;
        PG8_STAGE(PG8_SB(1, 0), cB + kstep, voffB); PG8_STAGE(PG8_SA(1, 0), cA + kstep, voffA); PG8_STAGE(PG8_SB(1, 1), cB + hstepB + kstep, voffB);
        PG8_WAIT_V(6); PG8_BAR;
    } else {
        PG8_STAGE(PG8_SB(0, 0), cB, voffB); PG8_STAGE(PG8_SA(0, 0), cA, voffA); PG8_STAGE(PG8_SB(0, 1), cB + hstepB, voffB); PG8_STAGE(PG8_SA(0, 1), cA + hstepA, voffA);
        if (wr == 1) PG8_BAR;
        PG8_WAIT_V(4); PG8_BAR;
        PG8_STAGE(PG8_SB(1, 0), cB + kstep, voffB); PG8_STAGE(PG8_SA(1, 0), cA + kstep, voffA); PG8_STAGE(PG8_SB(1, 1), cB + hstepB + kstep, voffB);
        PG8_WAIT_V(6); PG8_BAR;
    }
    for (;;) {
        const bool has_next = S.next(ui + 1, nxt);
        const char* nA = has_next ? (const char*)g.A + ((unsigned)nxt.pm * tstepA + (unsigned)nxt.pn * pnoff + (unsigned)nxt.seg * segoff) : cA; const char* nB = has_next ? (const char*)g.Bt + ((unsigned)nxt.pn * tstepB + (unsigned)nxt.seg * segoff) : cB;
        for (int t = 0; t < nt; t += 2) {
            const bool last = (t == nt - 2);
            const char* a1 = cA + (unsigned)(t + 1) * kstep;
            const char* a2 = last ? nA : cA + (unsigned)(t + 2) * kstep; const char* b2 = last ? nB : cB + (unsigned)(t + 2) * kstep;
            const char* a3 = a2 + kstep; const char* b3 = b2 + kstep;
            if (last && has_next) S.a_ready(nxt);
            if constexpr (SP2) {
            PG8_LDB(B0, 0, 0); PG8_LDB(B1, 0, 1); PG8_SCHED; PG8_LDA(At, 0, 0); PG8_STAGE(PG8_SA(1, 1), a1 + hstepA, voffA);
            PG8_WAIT_V(8); PG8_WAIT_L(0); PG8_BAR; PG8_MMA(0, 0, At, B0); PG8_MMA(0, 1, At, B1); PG8_BAR; PG8_SCHED;
            PG8_LDA(At, 0, 1); PG8_STAGE(PG8_SB(0, 0), b2, voffB); PG8_STAGE(PG8_SB(0, 1), b2 + hstepB, voffB); PG8_STAGE(PG8_SA(0, 0), a2, voffA);
            PG8_WAIT_V(8); PG8_WAIT_L(0); PG8_BAR; PG8_MMA(1, 0, At, B0); PG8_MMA(1, 1, At, B1); PG8_BAR; PG8_SCHED;
            PG8_LDB(B0, 1, 0); PG8_LDB(B1, 1, 1); PG8_SCHED; PG8_LDA(At, 1, 0); PG8_STAGE(PG8_SA(0, 1), a2 + hstepA, voffA);
            PG8_WAIT_V(8); PG8_WAIT_L(0); PG8_BAR; PG8_MMA(0, 0, At, B0); PG8_MMA(0, 1, At, B1); PG8_BAR; PG8_SCHED;
            PG8_LDA(At, 1, 1); PG8_STAGE(PG8_SB(1, 0), b3, voffB); PG8_STAGE(PG8_SB(1, 1), b3 + hstepB, voffB); PG8_STAGE(PG8_SA(1, 0), a3, voffA);
            PG8_WAIT_V(8); PG8_WAIT_L(0); PG8_BAR; PG8_MMA(1, 0, At, B0); PG8_MMA(1, 1, At, B1); PG8_BAR; PG8_SCHED;
            } else {
            PG8_LDB(B0, 0, 0); PG8_SCHED; PG8_LDA(At, 0, 0); PG8_STAGE(PG8_SA(1, 1), a1 + hstepA, voffA);
            PG8_WAIT_L(8); PG8_BAR; PG8_WAIT_L(0); PG8_MMA(0, 0, At, B0); PG8_BAR; PG8_SCHED;
            PG8_LDB(B1, 0, 1); PG8_STAGE(PG8_SB(0, 0), b2, voffB);
            PG8_BAR; PG8_WAIT_L(0); PG8_MMA(0, 1, At, B1); PG8_BAR;
            PG8_LDA(At, 0, 1); PG8_STAGE(PG8_SA(0, 0), a2, voffA);
            PG8_BAR; PG8_WAIT_L(0); PG8_MMA(1, 0, At, B0); PG8_BAR; PG8_SCHED;
            PG8_STAGE(PG8_SB(0, 1), b2 + hstepB, voffB);
            PG8_WAIT_V(6); PG8_BAR; PG8_MMA(1, 1, At, B1); PG8_BAR;
            PG8_LDB(B0, 1, 0); PG8_SCHED; PG8_LDA(At, 1, 0); PG8_STAGE(PG8_SA(0, 1), a2 + hstepA, voffA);
            PG8_WAIT_L(8); PG8_BAR; PG8_WAIT_L(0); PG8_MMA(0, 0, At, B0); PG8_BAR; PG8_SCHED;
            PG8_LDB(B1, 1, 1); PG8_STAGE(PG8_SB(1, 0), b3, voffB);
            PG8_BAR; PG8_WAIT_L(0); PG8_MMA(0, 1, At, B1); PG8_BAR;
            PG8_LDA(At, 1, 1); PG8_STAGE(PG8_SA(1, 0), a3, voffA);
            PG8_BAR; PG8_WAIT_L(0); PG8_MMA(1, 0, At, B0); PG8_BAR; PG8_SCHED;
            PG8_STAGE(PG8_SB(1, 1), b3 + hstepB, voffB);
            PG8_WAIT_V(6); PG8_BAR; PG8_MMA(1, 1, At, B1); PG8_BAR;
            }
        }
        if constexpr (ALIGN_EPI) { if (wr == 0) PG8_BAR; }
        if constexpr (!Epi::AFTER_DRAIN) { int l2; asm volatile("v_mbcnt_lo_u32_b32 %0, -1, 0\n\tv_mbcnt_hi_u32_b32 %0, -1, %0" : "=v"(l2)); E(acc, cur, wr, wc, l2 & 15, l2 >> 4); S.done(cur); }
        if (!has_next) break;
        if (!Epi::KHOOK || cur.seg == 3)
#pragma unroll
        for (int a = 0; a < 2; ++a)
#pragma unroll
            for (int b = 0; b < 2; ++b)
#pragma unroll
                for (int m = 0; m < 4; ++m)
#pragma unroll
                    for (int n = 0; n < 2; ++n) acc[a][b][m][n] = (f32x4){0.f, 0.f, 0.f, 0.f};
        cur = nxt; cA = nA; cB = nB; ++ui;
        if constexpr (ALIGN_EPI) { if (wr == 1) PG8_BAR; }
    }
    PG8_WAIT_V(0);
    if constexpr (!ALIGN_EPI) { if (wr == 0) PG8_BAR; }
    PG8_BAR;
    if constexpr (Epi::AFTER_DRAIN) { E.fused(acc, cur, wr, wc, fr, fq, lds, wid, lane); S.done(cur); }
#undef PG8_SA
#undef PG8_SB
#undef PG8_STAGE
#undef PG8_LDA
#undef PG8_LDB
#undef PG8_MMA
#undef PG8_WAIT_V
#undef PG8_WAIT_L
#undef PG8_BAR
#undef PG8_SCHED
}
}

constexpr int DM = 2048, NB = 4, SEQ = 2048, MTOK = NB * SEQ, DEPTH = 2;
constexpr int WBR = 512, INC = 11264, PCOLS = 3072, DFF = 8192;
constexpr float EPS = 1e-6f;
constexpr int NTHREADS = 512, NWAVES = 8;
constexpr int LDS_BYTES = 147456, LDS_ST_OFF = 147392;

constexpr size_t MiB = (size_t)1 << 20;
constexpr size_t WS_WIN = 0, WS_WFF1 = 88 * MiB, WS_WFF2 = 152 * MiB, WS_WO = 216 * MiB, WS_WBR = 232 * MiB, WS_WGLU = 248 * MiB, WS_WPOOL = 250 * MiB, WS_SEND = 251 * MiB;
constexpr size_t WS_BAR = 253 * MiB;
constexpr size_t WS_H = 254 * MiB, WS_P = 286 * MiB, WS_G = 334 * MiB, WS_YS = 462 * MiB, WS_Z = 494 * MiB, WS_POOLED = 502 * MiB, WS_MERGED = 510 * MiB, WS_MIX = 542 * MiB, WS_END = 640 * MiB;
constexpr size_t WS_KMAT = 606 * MiB, WS_W1T = 608 * MiB, WS_W2T = 624 * MiB, WS_L64 = WS_SEND;
constexpr size_t L_WIN = (size_t)INC * DM * 2, L_WFF = (size_t)DFF * DM * 2, L_WSQ = (size_t)DM * DM * 2, L_WGLU = (size_t)1024 * 512 * 2, L_WPOOL = (size_t)512 * 256 * 2;

typedef unsigned short bf16;
#define LAS __attribute__((address_space(3)))
typedef unsigned v4u __attribute__((ext_vector_type(4)));
typedef unsigned v2u __attribute__((ext_vector_type(2)));
typedef float v4f __attribute__((ext_vector_type(4)));
typedef float v2f __attribute__((ext_vector_type(2)));

struct Params { const float* in[29]; float* out; unsigned char* ws; };
typedef const Params __attribute__((address_space(4)))* KP;
__device__ __forceinline__ KP kargs() { KP q = (KP)__builtin_amdgcn_kernarg_segment_ptr(); asm volatile("" : "+s"(q)); return q; }

__device__ __forceinline__ unsigned f2bf(float f) { unsigned u = __float_as_uint(f); return (u + 0x7fffu + ((u >> 16) & 1u)) >> 16; }
__device__ __forceinline__ unsigned pk2(float lo, float hi) { return f2bf(lo) | (f2bf(hi) << 16); }
__device__ __forceinline__ float bflo(unsigned w) { return __uint_as_float(w << 16); }
__device__ __forceinline__ float bfhi(unsigned w) { return __uint_as_float(w & 0xffff0000u); }
__device__ __forceinline__ float bf1(const bf16* p) { return __uint_as_float(((unsigned)*p) << 16); }
__device__ __forceinline__ float sigmoid_f(float x) { return __builtin_amdgcn_rcpf(1.0f + __expf(-x)); }
__device__ __forceinline__ float gelu_tanh(float x) { const float y = 1.5957691216057308f * (x + 0.044715f * x * x * x); return x * __builtin_amdgcn_rcpf(1.0f + __expf(-y)); }
__device__ __forceinline__ float wave_sum(float v, int lane) {
#pragma unroll
    for (int o = 1; o < 64; o <<= 1) v += __builtin_bit_cast(float, __builtin_amdgcn_ds_bpermute((lane ^ o) << 2, __builtin_bit_cast(int, v)));
    return v;
}
#define LDS_WAIT() asm volatile("s_waitcnt lgkmcnt(0)" ::: "memory")

__device__ __forceinline__ void transpose_item(const float* W, int K, int N, bf16* WT, LAS float* scr, int item, int lane, int mode) {
    const int nblk = N / 32, kb = item / nblk, nb = item % nblk, k0 = 64 * kb, n0 = 32 * nb;
    int src0 = n0; if (mode == 1) { const int pn = n0 >> 8, bj = (n0 >> 7) & 1, j0 = n0 & 127; src0 = bj * 512 + pn * 128 + j0; }
#pragma unroll 8
    for (int i = 0; i < 32; ++i) { const int kk = 2 * i + (lane >> 5); scr[kk * 33 + (lane & 31)] = W[(size_t)(k0 + kk) * N + src0 + (lane & 31)]; }
    LDS_WAIT();
    const int c = lane & 7;
#pragma unroll
    for (int j = 0; j < 4; ++j) { const int n = (lane >> 3) + 8 * j; const LAS float* s = scr + (8 * c) * 33 + n;
        v4u o; o.x = pk2(s[0 * 33], s[1 * 33]); o.y = pk2(s[2 * 33], s[3 * 33]); o.z = pk2(s[4 * 33], s[5 * 33]); o.w = pk2(s[6 * 33], s[7 * 33]);
        *(v4u*)(WT + (size_t)(n0 + n) * K + k0 + 8 * c) = o; }
    LDS_WAIT();
}

__device__ __forceinline__ void rms_row_to_bf16(const float* xrow, const float* g, bf16* orow, int lane) {
    const v4f* xr = (const v4f*)xrow + lane; v4f v[8]; float s = 0.f;
#pragma unroll
    for (int j = 0; j < 8; ++j) { v[j] = xr[64 * j]; s += (v[j].x * v[j].x + v[j].y * v[j].y) + (v[j].z * v[j].z + v[j].w * v[j].w); }
    const float r = rsqrtf(wave_sum(s, lane) * (1.f / DM) + EPS);
    const v4f* gr = (const v4f*)g + lane; v2u* o8 = (v2u*)orow + lane;
#pragma unroll
    for (int j = 0; j < 8; ++j) { const v4f gg = gr[64 * j]; v2u o; o.x = pk2(v[j].x * r * gg.x, v[j].y * r * gg.y); o.y = pk2(v[j].z * r * gg.z, v[j].w * r * gg.w); o8[64 * j] = o; }
}
__device__ __forceinline__ void resid_norm_row(const float* yrow, const float* xi, float* xo, const float* g1, const float* g2, bf16* hn, int lane) {
    const v4f* yr = (const v4f*)yrow + lane; const v4f* xr = (const v4f*)xi + lane; v4f v[8]; float s = 0.f;
#pragma unroll
    for (int j = 0; j < 8; ++j) { v[j] = yr[64 * j]; s += (v[j].x * v[j].x + v[j].y * v[j].y) + (v[j].z * v[j].z + v[j].w * v[j].w); }
    const float r = rsqrtf(wave_sum(s, lane) * (1.f / DM) + EPS);
    const v4f* gr = (const v4f*)g1 + lane; v4f* xw = (v4f*)xo + lane; float s2 = 0.f;
#pragma unroll
    for (int j = 0; j < 8; ++j) { const v4f gg = gr[64 * j]; const v4f xx = xr[64 * j]; v[j] = xx + v[j] * r * gg; xw[64 * j] = v[j]; s2 += (v[j].x * v[j].x + v[j].y * v[j].y) + (v[j].z * v[j].z + v[j].w * v[j].w); }
    if (hn) { const float r2 = rsqrtf(wave_sum(s2, lane) * (1.f / DM) + EPS); const v4f* g2r = (const v4f*)g2 + lane; v2u* o8 = (v2u*)hn + lane;
#pragma unroll
        for (int j = 0; j < 8; ++j) { const v4f gg = g2r[64 * j]; v2u o; o.x = pk2(v[j].x * r2 * gg.x, v[j].y * r2 * gg.y); o.y = pk2(v[j].z * r2 * gg.z, v[j].w * r2 * gg.w); o8[64 * j] = o; } }
}

constexpr int SSM_KM_BYTES = 64 * 2 * 16 * 8 * 2;
typedef short bf16x8v __attribute__((ext_vector_type(8)));
__device__ __forceinline__ bf16x8v as_bf8(v4u x) { return __builtin_bit_cast(bf16x8v, x); }

__device__ __forceinline__ void ssm_tables_job(KP p, int l, int g, int tid, unsigned char* ws, LAS unsigned char* lds) {
    LAS float* lm = (LAS float*)lds; LAS float* ang = lm + 64;
    LAS v2f* Bb = (LAS v2f*)(lds + 1024); LAS v2f* Cc = (LAS v2f*)(lds + 1024 + 8192); LAS v2f* Lpow = (LAS v2f*)(lds + 1024 + 16384);
    bf16* W1t = (bf16*)(ws + WS_W1T) + (size_t)(l * 32 + g) * 128 * 1024; bf16* W2t = (bf16*)(ws + WS_W2T) + (size_t)(l * 32 + g) * 1024 * 128;
    bf16* Km = (bf16*)(ws + WS_KMAT) + (size_t)(l * 32 + g) * (SSM_KM_BYTES / 2); v2f* L64 = (v2f*)(ws + WS_L64) + (l * 32 + g) * 64;
    if (tid < 64) { const int n = tid;
        const float ar = p->in[3][(l * 32 + g) * 64 + n], ai = p->in[4][(l * 32 + g) * 64 + n], dt = expf(p->in[5][l * 32 + g]);
        const float lmv = ar * dt, an = ai * dt, mag = expf(lmv), lr = mag * cosf(an), li = mag * sinf(an), den = ar * ar + ai * ai;
        const float fr = ((lr - 1.0f) * ar + li * ai) / den, fi = (li * ar - (lr - 1.0f) * ai) / den;
        lm[n] = lmv; ang[n] = an;
        const float* br = p->in[6] + ((size_t)(l * 32 + g) * 64 + n) * 16; const float* bi = p->in[7] + ((size_t)(l * 32 + g) * 64 + n) * 16;
        for (int q = 0; q < 16; ++q) Bb[n * 16 + q] = (v2f){fr * br[q] - fi * bi[q], fr * bi[q] + fi * br[q]}; }
    for (int i = tid; i < 1024; i += NTHREADS) Cc[i] = (v2f){p->in[8][(size_t)(l * 32 + g) * 1024 + i], p->in[9][(size_t)(l * 32 + g) * 1024 + i]};
    __syncthreads();
    for (int e = tid; e < 65 * 64; e += NTHREADS) { const int m = e >> 6, n = e & 63; const float mg = expf((float)m * lm[n]), a = (float)m * ang[n]; Lpow[e] = (v2f){mg * cosf(a), mg * sinf(a)}; }
    __syncthreads();
    if (tid < 64) L64[tid] = Lpow[64 * 64 + tid];
    for (int e = tid; e < 4096; e += NTHREADS) { const int n = e & 63, tp = e >> 6; const v2f L = Lpow[(63 - tp) * 64 + n];
        unsigned re[8], im[8];
#pragma unroll
        for (int q = 0; q < 8; ++q) { const v2f b0 = Bb[n * 16 + 2 * q], b1 = Bb[n * 16 + 2 * q + 1];
            re[q] = pk2(L.x * b0.x - L.y * b0.y, L.x * b1.x - L.y * b1.y); im[q] = pk2(L.x * b0.y + L.y * b0.x, L.x * b1.y + L.y * b1.x); }
        v4u* o0 = (v4u*)(W1t + (size_t)(2 * n) * 1024 + tp * 16); v4u* o1 = (v4u*)(W1t + (size_t)(2 * n + 1) * 1024 + tp * 16);
        o0[0] = (v4u){re[0], re[1], re[2], re[3]}; o0[1] = (v4u){re[4], re[5], re[6], re[7]}; o1[0] = (v4u){im[0], im[1], im[2], im[3]}; o1[1] = (v4u){im[4], im[5], im[6], im[7]}; }
    for (int e = tid; e < 4096; e += NTHREADS) { const int n = e & 63, t = e >> 6; const v2f L = Lpow[(t + 1) * 64 + n];
        for (int q = 0; q < 16; ++q) { const v2f c = Cc[q * 64 + n]; ((unsigned*)W2t)[((size_t)(t * 16 + q) * 128 + 2 * n) >> 1] = pk2(c.x * L.x - c.y * L.y, -(c.x * L.y + c.y * L.x)); } }
    for (int it = tid; it < 2048; it += NTHREADS) { const int d = it >> 5, pp = (it >> 1) & 15, h = it & 1;
        float acc[8] = {0.f, 0.f, 0.f, 0.f, 0.f, 0.f, 0.f, 0.f};
        for (int n = 0; n < 64; ++n) { const v2f L = Lpow[d * 64 + n], c = Cc[pp * 64 + n]; const float gr = c.x * L.x - c.y * L.y, gi = c.x * L.y + c.y * L.x;
#pragma unroll
            for (int q = 0; q < 8; ++q) { const v2f bb = Bb[n * 16 + 8 * h + q]; acc[q] = fmaf(gr, bb.x, acc[q]); acc[q] = fmaf(-gi, bb.y, acc[q]); } }
        *(v4u*)(Km + (size_t)((d * 2 + h) * 16 + pp) * 8) = (v4u){pk2(acc[0], acc[1]), pk2(acc[2], acc[3]), pk2(acc[4], acc[5]), pk2(acc[6], acc[7])}; }
    __syncthreads();
}

__device__ __forceinline__ void ssm_seq_job(KP p, int l, int job, int tid, int wave, int lane, const bf16* P, bf16* Z, unsigned char* ws, LAS unsigned char* lds) {
    const int rbk = job & 1, g = (job >> 1) & 31, b = job >> 6, fr = lane & 15, fq = lane >> 4;
    LAS unsigned char* KmL = lds; LAS float* S = (LAS float*)(lds + 32768); LAS unsigned char* Cb = lds + 32768 + 32 * 132 * 4; LAS unsigned char* UL = lds + 32768 + 32 * 132 * 4 + 32 * 272;
    { const v4u* src = (const v4u*)(ws + WS_KMAT + (size_t)(l * 32 + g) * SSM_KM_BYTES);
#pragma unroll
      for (int i = 0; i < 4; ++i) *(LAS v4u*)(KmL + (tid + i * NTHREADS) * 16) = src[tid + i * NTHREADS]; }
#pragma unroll
    for (int i = 0; i < 4; ++i) { const int t = tid + i * NTHREADS; const v4u* src = (const v4u*)(P + ((size_t)b * SEQ + t) * PCOLS + g * 16); const v4u x0 = src[0], x1 = src[1];
        LAS v4u* dst = (LAS v4u*)(UL + (t >> 6) * 2064 + (t & 63) * 32); dst[0] = x0; dst[1] = x1; }
    __syncthreads();
    const bf16* W1t = (const bf16*)(ws + WS_W1T) + (size_t)(l * 32 + g) * 128 * 1024; const bf16* W2t = (const bf16*)(ws + WS_W2T) + (size_t)(l * 32 + g) * 1024 * 128;
    const LAS unsigned char* Ub = UL + fr * 2064 + fq * 16;
    pg8::f32x4 acc;
    { v4u w1[32]; const bf16* wb = W1t + (size_t)(16 * wave + fr) * 1024 + 8 * fq;
#pragma unroll
      for (int j = 0; j < 32; ++j) w1[j] = *(const v4u*)(wb + 32 * j);
#pragma unroll
      for (int rb1 = 0; rb1 < 2; ++rb1) {
        acc = (pg8::f32x4){0.f, 0.f, 0.f, 0.f};
        const LAS unsigned char* ub = Ub + rb1 * 16 * 2064;
#pragma unroll
        for (int j = 0; j < 32; ++j) { const v4u a = *(const LAS v4u*)(ub + j * 64);
            acc = __builtin_amdgcn_mfma_f32_16x16x32_bf16(as_bf8(w1[j]), as_bf8(a), acc, 0, 0, 0); }
        *(LAS pg8::f32x4*)(S + (rb1 * 16 + fr) * 132 + 16 * wave + 4 * fq) = acc;
      } }
    __syncthreads();
    if (tid < 64) { const v2f L = ((const v2f*)(ws + WS_L64))[(l * 32 + g) * 64 + tid]; float cr = 0.f, ci = 0.f;
        for (int c = 0; c < 32; ++c) { *(LAS unsigned*)(Cb + c * 272 + tid * 4) = pk2(cr, ci);
            const float sr = S[c * 132 + 2 * tid], si = S[c * 132 + 2 * tid + 1]; const float nr = L.x * cr - L.y * ci + sr, ni = L.x * ci + L.y * cr + si; cr = nr; ci = ni; } }
    __syncthreads();
    const float4 dsk = *(const float4*)(p->in[10] + l * 512 + g * 16 + 4 * fq);
    {
        v4u a[32]; const LAS unsigned char* ub = Ub + rbk * 16 * 2064;
#pragma unroll
        for (int j = 0; j < 32; ++j) a[j] = *(const LAS v4u*)(ub + j * 64);
#pragma unroll 1
        for (int i = 0; i < 8; ++i) { const int tau = wave + 8 * i;
            acc = (pg8::f32x4){0.f, 0.f, 0.f, 0.f};
            v4u w2c[4];
#pragma unroll
            for (int j = 0; j < 4; ++j) w2c[j] = *(const v4u*)(W2t + (size_t)(tau * 16 + fr) * 128 + 8 * fq + 32 * j);
#pragma unroll
            for (int j = 0; j < 32; ++j) if (2 * j <= tau) { int dl = tau - 2 * j - (fq >> 1); const bool ok = dl >= 0; dl = ok ? dl : 0;
                v4u kf = *(const LAS v4u*)(KmL + (((dl * 2 + (fq & 1)) * 16 + fr) * 8) * 2); if (!ok) kf = (v4u){0u, 0u, 0u, 0u};
                acc = __builtin_amdgcn_mfma_f32_16x16x32_bf16(as_bf8(kf), as_bf8(a[j]), acc, 0, 0, 0); }
#pragma unroll
            for (int j = 0; j < 4; ++j) { const v4u cfj = *(const LAS v4u*)(Cb + (rbk * 16 + fr) * 272 + (32 * j + 8 * fq) * 2);
                acc = __builtin_amdgcn_mfma_f32_16x16x32_bf16(as_bf8(w2c[j]), as_bf8(cfj), acc, 0, 0, 0); }
            const size_t row = (size_t)b * SEQ + (size_t)(rbk * 16 + fr) * 64 + tau;
            const v2u uu = *(const LAS v2u*)(UL + (rbk * 16 + fr) * 2064 + tau * 32 + 8 * fq);
            const float z0 = gelu_tanh(acc[0] + dsk.x * bflo(uu.x)), z1 = gelu_tanh(acc[1] + dsk.y * bfhi(uu.x)), z2 = gelu_tanh(acc[2] + dsk.z * bflo(uu.y)), z3 = gelu_tanh(acc[3] + dsk.w * bfhi(uu.y));
            *(v2u*)(Z + row * 512 + g * 16 + 4 * fq) = (v2u){pk2(z0, z1), pk2(z2, z3)}; }
    }
    __syncthreads();
}

__device__ __forceinline__ void pool_job(int job, int tid, const bf16* P, bf16* pooled) {
    const int b = job >> 6, t0 = (job & 63) * 32, c = tid, wsel = c >> 7;
    const bf16* U = P + (size_t)b * SEQ * PCOLS + 512 + c;
    float u[47];
#pragma unroll
    for (int i = 0; i < 47; ++i) { const int tt = t0 - 15 + i, tc = tt < 0 ? 0 : tt; const float x = bf1(U + (size_t)tc * PCOLS); u[i] = tt < 0 ? 0.f : x; }
    const int w = 2 << wsel;
#pragma unroll
    for (int i = 0; i < 32; ++i) { const int t = t0 + i;
        const float s2 = u[i + 15] + u[i + 14];
        const float s4 = s2 + (u[i + 13] + u[i + 12]);
        const float s8 = s4 + ((u[i + 11] + u[i + 10]) + (u[i + 9] + u[i + 8]));
        const float s16 = s8 + (((u[i + 7] + u[i + 6]) + (u[i + 5] + u[i + 4])) + ((u[i + 3] + u[i + 2]) + (u[i + 1] + u[i])));
        const float sum = wsel == 0 ? s2 : (wsel == 1 ? s4 : (wsel == 2 ? s8 : s16));
        const int cnt = (t + 1 < w) ? (t + 1) : w;
        pooled[((size_t)b * SEQ + t) * 512 + c] = (bf16)f2bf(sum / (float)cnt - u[i + 15]); }
}

__device__ __forceinline__ void conv_job(KP p, int l, int job, int tid, int wave, int lane, const bf16* P, bf16* ys, LAS unsigned char* lds) {
    const int b = job >> 7, t0 = (job & 127) * 16, c = tid;
    LAS float* Y = (LAS float*)lds;
    float v[46];
    const bf16* base = P + (size_t)b * SEQ * PCOLS + 1024 + c;
#pragma unroll
    for (int j = 0; j < 46; ++j) { const int tt = t0 - 30 + j, tc = tt < 0 ? 0 : tt;
        const float val = bf1(base + (size_t)tc * PCOLS), gate = bf1(base + (size_t)tc * PCOLS + 512); v[j] = tt < 0 ? 0.f : val * sigmoid_f(gate); }
    float y[16]; const float cb = p->in[15][l * 512 + c];
#pragma unroll
    for (int t = 0; t < 16; ++t) y[t] = cb;
#pragma unroll
    for (int k = 0; k < 31; ++k) { const float wk = p->in[14][(size_t)(l * 31 + k) * 512 + c];
#pragma unroll
        for (int t = 0; t < 16; ++t) y[t] = fmaf(wk, v[t + k], y[t]); }
#pragma unroll
    for (int t = 0; t < 16; ++t) Y[t * 512 + c] = y[t];
    __syncthreads();
#pragma unroll
    for (int q = 0; q < 2; ++q) { const int t = wave * 2 + q;
        const v4f a = *(const LAS v4f*)(Y + t * 512 + 8 * lane), bq = *(const LAS v4f*)(Y + t * 512 + 8 * lane + 4);
        float x[8] = {a.x, a.y, a.z, a.w, bq.x, bq.y, bq.z, bq.w};
        float s = 0.f;
#pragma unroll
        for (int i = 0; i < 8; ++i) s += x[i];
        const float mu = wave_sum(s, lane) * (1.f / 512.f); float s2 = 0.f;
#pragma unroll
        for (int i = 0; i < 8; ++i) { x[i] -= mu; s2 += x[i] * x[i]; }
        const float rstd = rsqrtf(wave_sum(s2, lane) * (1.f / 512.f) + EPS);
        const float* lg = p->in[16] + l * 512 + 8 * lane; const float* lb = p->in[17] + l * 512 + 8 * lane;
        float o[8];
#pragma unroll
        for (int i = 0; i < 8; ++i) { const float z = x[i] * rstd * lg[i] + lb[i]; o[i] = z * sigmoid_f(z); }
        v4u w; w.x = pk2(o[0], o[1]); w.y = pk2(o[2], o[3]); w.z = pk2(o[4], o[5]); w.w = pk2(o[6], o[7]);
        *(v4u*)(ys + ((size_t)b * SEQ + t0 + t) * DM + 1024 + 8 * lane) = w; }
    __syncthreads();
}

__device__ __forceinline__ void gmlp_job(KP p, int l, int job, int tid, int wave, int lane, const bf16* P, bf16* ys, LAS unsigned char* lds) {
    const int h = job & 3; const size_t row0 = (size_t)(job >> 2) * 128; const int fr = lane & 15, fq = lane >> 4;
    LAS unsigned char* vT = lds;
#pragma unroll 1
    for (int bt = 0; bt < 2; ++bt) { const int s0 = wave * 16 + bt * 8;
        v4u raw[8];
#pragma unroll
        for (int q = 0; q < 8; ++q) raw[q] = *(const v4u*)(P + (row0 + s0 + q) * PCOLS + 2560 + 8 * lane);
        float x[8][8], sm[8];
#pragma unroll
        for (int q = 0; q < 8; ++q) { x[q][0] = bflo(raw[q].x); x[q][1] = bfhi(raw[q].x); x[q][2] = bflo(raw[q].y); x[q][3] = bfhi(raw[q].y); x[q][4] = bflo(raw[q].z); x[q][5] = bfhi(raw[q].z); x[q][6] = bflo(raw[q].w); x[q][7] = bfhi(raw[q].w);
            float a = 0.f;
#pragma unroll
            for (int i = 0; i < 8; ++i) { x[q][i] = gelu_tanh(x[q][i]); a += x[q][i]; }
            sm[q] = a; }
#pragma unroll
        for (int o = 1; o < 64; o <<= 1) {
#pragma unroll
            for (int q = 0; q < 8; ++q) sm[q] += __builtin_bit_cast(float, __builtin_amdgcn_ds_bpermute((lane ^ o) << 2, __builtin_bit_cast(int, sm[q]))); }
#pragma unroll
        for (int q = 0; q < 8; ++q) { const float mu = sm[q] * (1.f / 512.f); float a = 0.f;
#pragma unroll
            for (int i = 0; i < 8; ++i) { x[q][i] -= mu; a += x[q][i] * x[q][i]; }
            sm[q] = a; }
#pragma unroll
        for (int o = 1; o < 64; o <<= 1) {
#pragma unroll
            for (int q = 0; q < 8; ++q) sm[q] += __builtin_bit_cast(float, __builtin_amdgcn_ds_bpermute((lane ^ o) << 2, __builtin_bit_cast(int, sm[q]))); }
        if ((lane >> 4) == h) { const float* lg = p->in[18] + l * 512 + 8 * lane; const float* lb = p->in[19] + l * 512 + 8 * lane;
#pragma unroll
            for (int i = 0; i < 8; ++i) { const float gi = lg[i], bi = lb[i]; const int d = 8 * (lane & 15) + i;
#pragma unroll
                for (int q = 0; q < 8; q += 2) { const float r0 = rsqrtf(sm[q] * (1.f / 512.f) + EPS), r1 = rsqrtf(sm[q + 1] * (1.f / 512.f) + EPS);
                    *(LAS unsigned*)(vT + d * 272 + (s0 + q) * 2) = pk2(x[q][i] * r0 * gi + bi, x[q + 1][i] * r1 * gi + bi); } } }
    }
    __syncthreads();
    const int t = 16 * wave + fr, nks = (wave >> 1) + 1;
    const float* Wsh = p->in[20] + (size_t)(l * 4 + h) * 128 * 128 + (size_t)t * 128; const float bias = p->in[21][(l * 4 + h) * 128 + t];
    v4u af[4];
#pragma unroll
    for (int j = 0; j < 4; ++j) { af[j] = (v4u){0u, 0u, 0u, 0u};
        if (j < nks) { const int sb = 32 * j + 8 * fq; const v4f w0 = *(const v4f*)(Wsh + sb), w1 = *(const v4f*)(Wsh + sb + 4);
            float wv[8] = {w0.x, w0.y, w0.z, w0.w, w1.x, w1.y, w1.z, w1.w};
#pragma unroll
            for (int i = 0; i < 8; ++i) wv[i] = __uint_as_float(__float_as_uint(wv[i]) & ~(unsigned)((t - sb - i) >> 31));
            af[j] = (v4u){pk2(wv[0], wv[1]), pk2(wv[2], wv[3]), pk2(wv[4], wv[5]), pk2(wv[6], wv[7])}; } }
    v2u uu[8];
#pragma unroll
    for (int cb = 0; cb < 8; ++cb) uu[cb] = *(const v2u*)(P + (row0 + t) * PCOLS + 2048 + h * 128 + 16 * cb + 4 * fq);
#pragma unroll
    for (int cb = 0; cb < 8; ++cb) { pg8::f32x4 acc = (pg8::f32x4){0.f, 0.f, 0.f, 0.f};
#pragma unroll
        for (int j = 0; j < 4; ++j) if (j < nks) { const v4u bfr = *(const LAS v4u*)(vT + (16 * cb + fr) * 272 + (32 * j + 8 * fq) * 2);
            acc = __builtin_amdgcn_mfma_f32_16x16x32_bf16(as_bf8(bfr), as_bf8(af[j]), acc, 0, 0, 0); }
        const float o0 = gelu_tanh(bflo(uu[cb].x)) * (acc[0] + bias), o1 = gelu_tanh(bfhi(uu[cb].x)) * (acc[1] + bias), o2 = gelu_tanh(bflo(uu[cb].y)) * (acc[2] + bias), o3 = gelu_tanh(bfhi(uu[cb].y)) * (acc[3] + bias);
        *(v2u*)(ys + (row0 + t) * DM + 1536 + h * 128 + 16 * cb + 4 * fq) = (v2u){pk2(o0, o1), pk2(o2, o3)}; }
    __syncthreads();
}

#define XB_TMO      128
#define XB_XCNT(j)  (256  + 64 * (j))
#define XB_XSUB(j)  (1280 + 64 * (j))
#define XB_XGEN(j)  (2304 + 64 * (j))
#define XB_TOP      3328
#define XB_TOPGEN   3392
#define XCD_BAR_WORDS 3456
#define XB_SPIN_CAP (1u << 18)
__device__ __forceinline__ unsigned xb_ld(unsigned* p)              { return __hip_atomic_load(p, __ATOMIC_RELAXED, __HIP_MEMORY_SCOPE_AGENT); }
__device__ __forceinline__ unsigned xb_add(unsigned* p, unsigned v) { return __hip_atomic_fetch_add(p, v, __ATOMIC_RELAXED, __HIP_MEMORY_SCOPE_AGENT); }
__device__ __forceinline__ unsigned xb_xcc_id() { return (unsigned)__builtin_amdgcn_s_getreg((3 << 11) | 20) & 0xFu; }
#define XB_SPIN(cond, bar) do { unsigned _sp = 0; while (cond) { __builtin_amdgcn_s_sleep(1); \
    if ((++_sp & 255u) == 0u) { if (xb_ld(&(bar)[XB_TMO])) break; if (_sp > XB_SPIN_CAP) { atomicAdd(&(bar)[XB_TMO], 1u); break; } } } } while (0)
__device__ __forceinline__ void xcd_barrier_complete(unsigned* bar, unsigned x, unsigned G, unsigned& nloc, unsigned& nx) {
    unsigned sum, cnt, mine, sp = 0u;
    for (;;) {
        sum = 0u; cnt = 0u; mine = 0u;
#pragma unroll
        for (unsigned j = 0; j < 16; ++j) { const unsigned c = xb_ld(&bar[XB_XCNT(j)]); sum += c; cnt += (c > 0u) ? 1u : 0u; mine = (j == x) ? c : mine; }
        if (sum == G) break;
        __builtin_amdgcn_s_sleep(1);
        if ((++sp & 255u) == 0u) { if (xb_ld(&bar[XB_TMO])) break; if (sp > XB_SPIN_CAP) { atomicAdd(&bar[XB_TMO], 1u); break; } }
    }
    nloc = mine > 0u ? mine : 1u; nx = cnt > 0u ? cnt : 1u;
}
__device__ __forceinline__ void xcd_barrier(unsigned* bar, volatile LAS unsigned* st, bool first, unsigned G) {
    asm volatile("s_waitcnt vmcnt(0)" ::: "memory");
    __syncthreads();
    if (first) {
        const unsigned x = xb_xcc_id();
        __builtin_amdgcn_s_waitcnt(0);
        unsigned nloc = st[0], nx = st[1];
        if (nloc == 0u) { xcd_barrier_complete(bar, x, G, nloc, nx); st[0] = nloc; st[1] = nx; }
        const unsigned old = xb_add(&bar[XB_XSUB(x)], 1u);
        const unsigned gen = old / nloc;
        if (old + 1u == (gen + 1u) * nloc) {
            __builtin_amdgcn_fence(__ATOMIC_RELEASE, "agent");
            asm volatile("s_waitcnt vmcnt(0)" ::: "memory");
            const unsigned og = xb_add(&bar[XB_TOP], 1u);
            const unsigned tg = og / nx;
            if (og + 1u == (tg + 1u) * nx) xb_add(&bar[XB_TOPGEN], 1u);
            else XB_SPIN(xb_ld(&bar[XB_TOPGEN]) == tg, bar);
            __builtin_amdgcn_fence(__ATOMIC_ACQUIRE, "agent");
            xb_add(&bar[XB_XGEN(x)], 1u);
            asm volatile("s_waitcnt vmcnt(0)" ::: "memory");
        } else {
            XB_SPIN(xb_ld(&bar[XB_XGEN(x)]) == gen, bar);
            __builtin_amdgcn_fence(__ATOMIC_ACQUIRE, "agent");
            asm volatile("s_waitcnt vmcnt(0)" ::: "memory");
        }
    }
    __syncthreads();
}

#ifndef PHMASK
#define PHMASK 0xFFFFFFFFu
#endif
#ifndef JOBMASK
#define JOBMASK 0xFu
#endif
#ifndef JOBREP
#define JOBREP 0
#endif
#ifndef PHREP
#define PHREP 0u
#endif
#define NREP(k) (1 + (int)((PHREP >> (k)) & 1u))
#define PH_BEGIN() KP p = kargs(); int wave = wave_s; asm volatile("" : "+s"(wave)); int lane; asm volatile("v_mbcnt_lo_u32_b32 %0, -1, 0\n\tv_mbcnt_hi_u32_b32 %0, -1, %0" : "=v"(lane)); const int tid = wave * 64 + lane; \
    int bid = blockIdx.x, G = gridDim.x; asm volatile("" : "+s"(bid), "+s"(G)); const int gw = bid * NWAVES + wave, NGW = G * NWAVES; unsigned char* ws = p->ws; (void)lane; (void)gw; (void)NGW; (void)ws
#define GRID_BAR() do { KP q_ = kargs(); int w_ = wave_s; asm volatile("" : "+s"(w_)); int l_; asm volatile("v_mbcnt_lo_u32_b32 %0, -1, 0\n\tv_mbcnt_hi_u32_b32 %0, -1, %0" : "=v"(l_)); \
    xcd_barrier((unsigned*)(q_->ws + WS_BAR), (volatile LAS unsigned*)(lds + LDS_ST_OFF), (w_ == 0 && l_ == 0), (unsigned)gridDim.x); } while (0)
__global__ void __launch_bounds__(NTHREADS, 2) hybrid_fwd(Params p_unused) {
    extern __shared__ __attribute__((aligned(16))) unsigned char lds_raw[];
    LAS unsigned char* lds = (LAS unsigned char*)lds_raw;
    cg::grid_group grid = cg::this_grid();
    const int wave_s = __builtin_amdgcn_readfirstlane((int)threadIdx.x >> 6);

    { PH_BEGIN(); if (tid < 2) ((LAS unsigned*)(lds + LDS_ST_OFF))[tid] = 0u;
      if (bid == 0) for (int i = tid; i < XCD_BAR_WORDS; i += NTHREADS) ((unsigned*)(ws + WS_BAR))[i] = 0u; }
    if (PHMASK & (1u << 0)) { PH_BEGIN();
        LAS float* scr = (LAS float*)(lds + wave * 16384);
        constexpr int I_IN = (DM / 64) * (INC / 32), I_FF1 = (DM / 64) * (DFF / 32), I_FF2 = (DFF / 64) * (DM / 32), I_SQ = (DM / 64) * (DM / 32), I_GLU = (512 / 64) * (1024 / 32);
        constexpr int PER_L = I_IN + I_FF1 + I_FF2 + 2 * I_SQ + I_GLU;
        for (int it0 = gw; it0 < DEPTH * PER_L * NREP(0); it0 += NGW) { const int it = it0 % (DEPTH * PER_L);
            const int l = it / PER_L; int r = it % PER_L;
            if (r < I_IN) { transpose_item(p->in[2] + (size_t)l * DM * INC, DM, INC, (bf16*)(ws + WS_WIN + l * L_WIN), scr, r, lane, 0); continue; } r -= I_IN;
            if (r < I_FF1) { transpose_item(p->in[26] + (size_t)l * DM * DFF, DM, DFF, (bf16*)(ws + WS_WFF1 + l * L_WFF), scr, r, lane, 0); continue; } r -= I_FF1;
            if (r < I_FF2) { transpose_item(p->in[27] + (size_t)l * DFF * DM, DFF, DM, (bf16*)(ws + WS_WFF2 + l * L_WFF), scr, r, lane, 0); continue; } r -= I_FF2;
            if (r < I_SQ) { transpose_item(p->in[23] + (size_t)l * DM * DM, DM, DM, (bf16*)(ws + WS_WO + l * L_WSQ), scr, r, lane, 0); continue; } r -= I_SQ;
            if (r < I_SQ) { transpose_item(p->in[22] + (size_t)l * DM * DM, DM, DM, (bf16*)(ws + WS_WBR + l * L_WSQ), scr, r, lane, 0); continue; } r -= I_SQ;
            transpose_item(p->in[11] + (size_t)l * 512 * 1024, 512, 1024, (bf16*)(ws + WS_WGLU + l * L_WGLU), scr, r, lane, 1);
        }
        __syncthreads();
        for (int j = G - 1 - bid; j < DEPTH * 32; j += G) ssm_tables_job(p, j >> 5, j & 31, tid, ws, lds);
        for (int i = bid * NTHREADS + tid; i < DEPTH * 512 * 256; i += G * NTHREADS) { const int l = i / (512 * 256), r = i % (512 * 256), n = r >> 8, kk = r & 255, g = n >> 7, d = n & 127, cc = kk - 128 * (g & 1);
            const float v = (cc >= 0 && cc < 128) ? p->in[12][((size_t)(l * 4 + g) * 128 + cc) * 128 + d] : 0.f;
            ((bf16*)(ws + WS_WPOOL + l * L_WPOOL))[r] = (bf16)f2bf(v); }
        for (int m = gw; m < MTOK; m += NGW) rms_row_to_bf16(p->in[0] + (size_t)m * DM, p->in[1], (bf16*)(ws + WS_H) + (size_t)m * DM, lane);
    }
    grid.sync();
    { PH_BEGIN(); if (tid == 0) (void)xb_add(&((unsigned*)(ws + WS_BAR))[XB_XCNT(xb_xcc_id())], 1u); }

#pragma unroll 1
    for (int l = 0; l < DEPTH; ++l) {
        if (PHMASK & (1u << 1)) { PH_BEGIN();
          pg8::Gemm g{(const bf16*)(ws + WS_H), (const bf16*)(ws + WS_WIN + l * L_WIN), MTOK, INC, DM, DM, DM, 0}; pg8::StaticOrder S; S.init(MTOK, INC, G, bid); S.reps = NREP(1);
          pg8::EpiBf16<0> E{(bf16*)(ws + WS_P), PCOLS, (bf16*)(ws + WS_G), 8192, nullptr, 0};
          pg8::gemm_phase<pg8::EpiBf16<0>, pg8::StaticOrder, true, true>(lds, g, S, E, wave, lane); }
        GRID_BAR();
        if (PHMASK & (1u << 2)) { PH_BEGIN();
          const bf16* Pb = (const bf16*)(ws + WS_P); bf16* YS = (bf16*)(ws + WS_YS);
          constexpr int J0 = 256 * (1 + (JOBREP & 1)), J1 = J0 + 256 * (1 + ((JOBREP >> 1) & 1)), J2 = J1 + 512 * (1 + ((JOBREP >> 2) & 1)), J3 = J2 + 256 * (1 + ((JOBREP >> 3) & 1));
          for (int j0 = bid; j0 < J3 * NREP(2); j0 += G) { const int j = j0 % J3;
            if (j < J0) { if (JOBMASK & 1u) ssm_seq_job(p, l, j % 256, tid, wave, lane, Pb, (bf16*)(ws + WS_Z), ws, lds); }
            else if (j < J1) { if (JOBMASK & 2u) gmlp_job(p, l, (j - J0) % 256, tid, wave, lane, Pb, YS, lds); }
            else if (j < J2) { if (JOBMASK & 4u) conv_job(p, l, (j - J1) % 512, tid, wave, lane, Pb, YS, lds); }
            else { if (JOBMASK & 8u) pool_job((j - J2) % 256, tid, Pb, (bf16*)(ws + WS_POOLED)); }
          } }
        GRID_BAR();
        if (PHMASK & (1u << 4)) { PH_BEGIN();
          const bool split = (G >= 192);
          pg8::Gemm g{(const bf16*)(ws + WS_Z), (const bf16*)(ws + WS_WGLU + l * L_WGLU), MTOK, 1024, 512, 512, 512, 0}; pg8::StaticOrder S; S.init(MTOK, 1024, split ? 128 : G, split ? (bid < 128 ? bid : -1) : bid); S.reps = NREP(4);
          pg8::EpiGlu E{(bf16*)(ws + WS_YS), DM};
          pg8::gemm_phase<pg8::EpiGlu, pg8::StaticOrder, true, true>(lds, g, S, E, wave, lane); }
        if (PHMASK & (1u << 4)) { PH_BEGIN();
          const bool split = (G >= 192);
          pg8::Gemm g{(const bf16*)(ws + WS_POOLED), (const bf16*)(ws + WS_WPOOL + l * L_WPOOL), MTOK, 512, 256, 512, 256, 256}; pg8::StaticOrder S; S.init(MTOK, 512, split ? 64 : G, split ? ((bid >= 128 && bid < 192) ? bid - 128 : -1) : bid); S.reps = NREP(4);
          pg8::EpiBf16<2> E{(bf16*)(ws + WS_YS), DM, nullptr, 0, p->in[13] + l * 512, 512};
          pg8::gemm_phase<pg8::EpiBf16<2>, pg8::StaticOrder, true, true>(lds, g, S, E, wave, lane); }
        GRID_BAR();
        if (PHMASK & (1u << 5)) { PH_BEGIN();
          pg8::Gemm g{(const bf16*)(ws + WS_YS), (const bf16*)(ws + WS_WBR + l * L_WSQ), MTOK, DM, 512, DM, DM, 0}; pg8::SegOrder S; S.init(MTOK, DM, G, bid); S.reps = NREP(5);
          pg8::EpiBranch E{(bf16*)(ws + WS_MERGED), DM, (const bf16*)(ws + WS_G)};
          pg8::gemm_phase<pg8::EpiBranch, pg8::SegOrder, true, true>(lds, g, S, E, wave, lane); }
        GRID_BAR();
        if (PHMASK & (1u << 6)) { PH_BEGIN();
          pg8::Gemm g{(const bf16*)(ws + WS_MERGED), (const bf16*)(ws + WS_WO + l * L_WSQ), MTOK, DM, DM, DM, DM, 0}; pg8::StaticOrder S; S.init(MTOK, DM, G, bid); S.reps = NREP(6);
          pg8::EpiF32 E{(float*)(ws + WS_MIX), DM};
          pg8::gemm_phase<pg8::EpiF32, pg8::StaticOrder, true, true>(lds, g, S, E, wave, lane); }
        GRID_BAR();
        if (PHMASK & (1u << 7)) { PH_BEGIN();
          const float* xin = (l == 0) ? p->in[0] : p->out; float* xo = p->out; const float* MIX = (const float*)(ws + WS_MIX); bf16* Hb = (bf16*)(ws + WS_H);
          for (int m = gw; m < MTOK; m += NGW) resid_norm_row(MIX + (size_t)m * DM, xin + (size_t)m * DM, xo + (size_t)m * DM, p->in[24] + l * DM, p->in[25] + l * DM, Hb + (size_t)m * DM, lane); }
        GRID_BAR();
        if (PHMASK & (1u << 8)) { PH_BEGIN();
          pg8::Gemm g{(const bf16*)(ws + WS_H), (const bf16*)(ws + WS_WFF1 + l * L_WFF), MTOK, DFF, DM, DM, DM, 0}; pg8::StaticOrder S; S.init(MTOK, DFF, G, bid); S.reps = NREP(8);
          pg8::EpiBf16<1> E{(bf16*)(ws + WS_G), DFF, nullptr, 0, nullptr, 0};
          pg8::gemm_phase<pg8::EpiBf16<1>, pg8::StaticOrder, true, true>(lds, g, S, E, wave, lane); }
        GRID_BAR();
        if (PHMASK & (1u << 9)) { PH_BEGIN();
          pg8::Gemm g{(const bf16*)(ws + WS_G), (const bf16*)(ws + WS_WFF2 + l * L_WFF), MTOK, DM, DFF, DFF, DFF, 0}; pg8::StaticOrder S; S.init(MTOK, DM, G, bid); S.reps = NREP(9);
          pg8::EpiF32 E{(float*)(ws + WS_MIX), DM};
          pg8::gemm_phase<pg8::EpiF32, pg8::StaticOrder, true, true>(lds, g, S, E, wave, lane); }
        GRID_BAR();
        if (PHMASK & (1u << 10)) { PH_BEGIN();
          const bool more = (l + 1 < DEPTH); float* xo = p->out; const float* MIX = (const float*)(ws + WS_MIX); bf16* Hb = (bf16*)(ws + WS_H);
          for (int m = gw; m < MTOK; m += NGW) resid_norm_row(MIX + (size_t)m * DM, xo + (size_t)m * DM, xo + (size_t)m * DM, p->in[28] + l * DM, more ? p->in[1] + (l + 1) * DM : nullptr, more ? Hb + (size_t)m * DM : nullptr, lane); }
        if (l + 1 < DEPTH) GRID_BAR();
    }
}

extern "C" void kernel_launch(void* const* d_in, const int* in_sizes, int n_in, void* d_out, int out_size, void* d_ws, size_t ws_size, hipStream_t stream) {
    static int grid = 0;
    if (grid == 0) {
        if (n_in != 29 || out_size != MTOK * DM || ws_size < WS_END) { fprintf(stderr, "kernel_launch: unexpected shapes (n_in %d, out %d, ws %zu < %zu)\n", n_in, out_size, ws_size, (size_t)WS_END); grid = -1; return; }
        int dev = 0, cus = 0, per_cu = 0;
        if (hipGetDevice(&dev) != hipSuccess || hipDeviceGetAttribute(&cus, hipDeviceAttributeMultiprocessorCount, dev) != hipSuccess) { grid = -1; return; }
        if (hipFuncSetAttribute((const void*)hybrid_fwd, hipFuncAttributeMaxDynamicSharedMemorySize, LDS_BYTES) != hipSuccess) { fprintf(stderr, "kernel_launch: hipFuncSetAttribute failed\n"); grid = -1; return; }
        if (hipOccupancyMaxActiveBlocksPerMultiprocessor(&per_cu, (const void*)hybrid_fwd, NTHREADS, LDS_BYTES) != hipSuccess || per_cu < 1) { fprintf(stderr, "kernel_launch: occupancy query says %d blocks/CU\n", per_cu); (void)hipGetLastError(); grid = -1; return; }
        grid = cus * per_cu; if (grid > 256) grid = 256;
    }
    if (grid < 0) return;
    Params p{};
    for (int i = 0; i < 29; ++i) p.in[i] = (const float*)d_in[i];
    p.out = (float*)d_out; p.ws = (unsigned char*)d_ws;
    void* args[] = {&p};
    hipError_t e = hipLaunchCooperativeKernel((const void*)hybrid_fwd, dim3(grid), dim3(NTHREADS), args, LDS_BYTES, stream);
    if (e != hipSuccess) fprintf(stderr, "cooperative launch failed: %s (grid %d)\n", hipGetErrorString(e), grid);
}
```
